# Optimizing an MI355X kernel written in HIP

```python
import math
import jax, jax.numpy as jnp
from jax import lax
import numpy as np

D_MODEL = 1024
BATCH = 16
SEQ = 2048
DEPTH = 4

HEAD_DIM = 64
N_HEADS_MIX = D_MODEL // HEAD_DIM
N_FOX = N_HEADS_MIX // 2
N_MOBA = N_HEADS_MIX - N_FOX
FOX_W = N_FOX * HEAD_DIM
MOBA_W = N_MOBA * HEAD_DIM
IN_COLS = 3 * FOX_W + N_FOX + 3 * MOBA_W
FOX_Q_BLOCK = 128
MOBA_BLOCK = 256
MOBA_TOPK = 3
MOBA_Q_CHUNK = 16
N_BUCKETS = 32
MAX_DISTANCE = 128
N_MEM = 256
N_CROSS_HEADS = 4
CROSS_HEAD_DIM = D_MODEL // N_CROSS_HEADS
N_EXPERTS = 32
TOP_K = 4
D_EXPERT = D_MODEL
SWIGLU_LIMIT = 7.0
SWIGLU_ALPHA = 1.702
EXPERT_BLOCK = 128
DEEPNORM_ALPHA = (2 * DEPTH) ** 0.25
DEEPNORM_BETA = (8 * DEPTH) ** -0.25
LN_EPS = 1e-5

kernel_name = "fox_moba_hymba_deepnorm_moe"


def layer_norm(x, g, b):
    x32 = x.astype(jnp.float32)
    mu = jnp.mean(x32, axis=-1, keepdims=True)
    var = jnp.mean(jnp.square(x32 - mu), axis=-1, keepdims=True)
    y = (x32 - mu) * lax.rsqrt(var + LN_EPS)
    return (y * g.astype(jnp.float32) + b.astype(jnp.float32)).astype(x.dtype)


def split_heads(t, n_heads, head_dim):
    B, S, _ = t.shape
    return t.reshape(B, S, n_heads, head_dim).transpose(0, 2, 1, 3)


def merge_heads(t):
    B, H, S, d = t.shape
    return t.transpose(0, 2, 1, 3).reshape(B, S, H * d)


def t5_bucket(dist):
    max_exact = N_BUCKETS // 2
    n = jnp.maximum(dist, 0)
    nf = jnp.maximum(n, 1).astype(jnp.float32)
    large = max_exact + (jnp.log(nf / max_exact) / math.log(MAX_DISTANCE / max_exact)
                         * (N_BUCKETS - max_exact)).astype(jnp.int32)
    large = jnp.minimum(large, N_BUCKETS - 1)
    return jnp.where(n < max_exact, n, large)


def fox_attention(q, k, v, log_f):
    B, H, S, d = q.shape
    c = jnp.cumsum(log_f, axis=-1)
    scale = d ** -0.5
    kpos = jnp.arange(S)

    def block(i):
        start = i * FOX_Q_BLOCK
        qb = lax.dynamic_slice_in_dim(q, start, FOX_Q_BLOCK, axis=2)
        cb = lax.dynamic_slice_in_dim(c, start, FOX_Q_BLOCK, axis=2)
        qpos = start + jnp.arange(FOX_Q_BLOCK)
        logits = jnp.einsum('bhqd,bhkd->bhqk', qb, k,
                            preferred_element_type=jnp.float32) * scale
        logits = logits + cb[..., :, None] - c[..., None, :]
        logits = jnp.where(kpos[None, :] <= qpos[:, None], logits, -jnp.inf)
        p = jax.nn.softmax(logits, axis=-1)
        return jnp.einsum('bhqk,bhkd->bhqd', p.astype(v.dtype), v)

    out = lax.map(block, jnp.arange(S // FOX_Q_BLOCK))
    return jnp.moveaxis(out, 0, 2).reshape(B, H, S, d)


def moba_attention(q, k, v, rel_bias):
    B, H, S, d = q.shape
    nblk = -(-S // MOBA_BLOCK)
    pad = nblk * MOBA_BLOCK - S
    kp = jnp.pad(k, ((0, 0), (0, 0), (0, pad), (0, 0)))
    vp = jnp.pad(v, ((0, 0), (0, 0), (0, pad), (0, 0)))
    kb = kp.reshape(B, H, nblk, MOBA_BLOCK, d)
    vb = vp.reshape(B, H, nblk, MOBA_BLOCK, d)
    kmean = jnp.mean(kb.astype(jnp.float32), axis=3)
    n_sel = min(MOBA_TOPK, nblk)
    scale = d ** -0.5
    bias_tab = rel_bias.T.astype(jnp.float32)
    bidx = jnp.arange(B)[:, None, None, None]
    hidx = jnp.arange(H)[None, :, None, None]
    hidx5 = jnp.arange(H)[None, :, None, None, None]
    offs = jnp.arange(MOBA_BLOCK)

    def chunk(ci):
        start = ci * MOBA_Q_CHUNK
        qc = lax.dynamic_slice_in_dim(q, start, MOBA_Q_CHUNK, axis=2)
        qpos = start + jnp.arange(MOBA_Q_CHUNK)
        own = start // MOBA_BLOCK
        gate = jnp.einsum('bhcd,bhnd->bhcn', qc.astype(jnp.float32), kmean)
        gate = jnp.where(jnp.arange(nblk) < own, gate, -jnp.inf)
        gval, sel = lax.top_k(gate, n_sel)
        sel_ok = gval > -jnp.inf
        ks = kb[bidx, hidx, sel]
        vs = vb[bidx, hidx, sel]
        lg_sel = jnp.einsum('bhcd,bhcnkd->bhcnk', qc, ks,
                            preferred_element_type=jnp.float32) * scale
        dist_sel = qpos[None, None, :, None, None] - (sel[..., None] * MOBA_BLOCK + offs)
        lg_sel = lg_sel + bias_tab[hidx5, t5_bucket(dist_sel)]
        lg_sel = jnp.where(sel_ok[..., None], lg_sel, -jnp.inf)
        k_own = lax.dynamic_slice_in_dim(kp, own * MOBA_BLOCK, MOBA_BLOCK, axis=2)
        v_own = lax.dynamic_slice_in_dim(vp, own * MOBA_BLOCK, MOBA_BLOCK, axis=2)
        lg_own = jnp.einsum('bhcd,bhkd->bhck', qc, k_own,
                            preferred_element_type=jnp.float32) * scale
        dist_own = qpos[:, None] - (own * MOBA_BLOCK + offs)[None, :]
        lg_own = lg_own + bias_tab[:, t5_bucket(dist_own)][None]
        lg_own = jnp.where(dist_own >= 0, lg_own, -jnp.inf)
        logits = jnp.concatenate(
            [lg_sel.reshape(B, H, MOBA_Q_CHUNK, n_sel * MOBA_BLOCK), lg_own], axis=-1)
        p = jax.nn.softmax(logits, axis=-1).astype(v.dtype)
        p_sel = p[..., :n_sel * MOBA_BLOCK].reshape(B, H, MOBA_Q_CHUNK, n_sel, MOBA_BLOCK)
        p_own = p[..., n_sel * MOBA_BLOCK:]
        return (jnp.einsum('bhcnk,bhcnkd->bhcd', p_sel, vs)
                + jnp.einsum('bhck,bhkd->bhcd', p_own, v_own))

    out = lax.map(chunk, jnp.arange(S // MOBA_Q_CHUNK))
    return jnp.moveaxis(out, 0, 2).reshape(B, H, S, d)


def hybrid_mixer(x, w_in, b_forget, w_out, rel_bias):
    proj = jnp.einsum('bsd,de->bse', x, w_in)
    cuts = [FOX_W, 2 * FOX_W, 3 * FOX_W, 3 * FOX_W + N_FOX,
            3 * FOX_W + N_FOX + MOBA_W, 3 * FOX_W + N_FOX + 2 * MOBA_W]
    q_f, k_f, v_f, f_logit, q_m, k_m, v_m = jnp.split(proj, cuts, axis=-1)
    log_f = jax.nn.log_sigmoid((f_logit + b_forget).astype(jnp.float32))
    log_f = log_f.transpose(0, 2, 1)
    o_f = fox_attention(split_heads(q_f, N_FOX, HEAD_DIM), split_heads(k_f, N_FOX, HEAD_DIM),
                        split_heads(v_f, N_FOX, HEAD_DIM), log_f)
    o_m = moba_attention(split_heads(q_m, N_MOBA, HEAD_DIM), split_heads(k_m, N_MOBA, HEAD_DIM),
                         split_heads(v_m, N_MOBA, HEAD_DIM), rel_bias)
    o = merge_heads(jnp.concatenate([o_f, o_m.astype(o_f.dtype)], axis=1))
    return jnp.einsum('bse,ed->bsd', o, w_out)


def memory_cross_attention(x, mem, w_q, w_k, w_v, w_o):
    q = split_heads(jnp.einsum('bsd,de->bse', x, w_q), N_CROSS_HEADS, CROSS_HEAD_DIM)
    k = split_heads(jnp.einsum('bmd,de->bme', mem, w_k), N_CROSS_HEADS, CROSS_HEAD_DIM)
    v = split_heads(jnp.einsum('bmd,de->bme', mem, w_v), N_CROSS_HEADS, CROSS_HEAD_DIM)
    logits = jnp.einsum('bhsd,bhmd->bhsm', q, k,
                        preferred_element_type=jnp.float32) * CROSS_HEAD_DIM ** -0.5
    p = jax.nn.softmax(logits, axis=-1).astype(v.dtype)
    o = merge_heads(jnp.einsum('bhsm,bhmd->bhsd', p, v))
    return jnp.einsum('bse,ed->bsd', o, w_o)


def moe_ffn(x, w_router, b_router, w_gate_up, b_gate_up, w_down, b_down):
    B, S, D = x.shape
    T = B * S
    TK = T * TOP_K
    xt = x.reshape(T, D)
    logits = (xt @ w_router + b_router).astype(jnp.float32)
    top_val, top_idx = lax.top_k(logits, TOP_K)
    gates = jax.nn.softmax(top_val, axis=-1)
    e_flat = top_idx.reshape(-1)
    order = jnp.argsort(e_flat)
    e_sorted = e_flat[order]
    counts = jnp.zeros((N_EXPERTS,), jnp.int32).at[e_flat].add(1)
    padded = ((counts + EXPERT_BLOCK - 1) // EXPERT_BLOCK) * EXPERT_BLOCK
    start = jnp.cumsum(counts) - counts
    pend = jnp.cumsum(padded)
    pstart = pend - padded
    rank = jnp.arange(TK, dtype=jnp.int32) - start[e_sorted]
    dest = jnp.zeros((TK,), jnp.int32).at[order].set(pstart[e_sorted] + rank)
    n_blocks = -(-TK // EXPERT_BLOCK) + N_EXPERTS
    n_pad = n_blocks * EXPERT_BLOCK
    slot_token = jnp.full((n_pad,), T, jnp.int32).at[dest].set(
        jnp.arange(TK, dtype=jnp.int32) // TOP_K)
    x_pad = jnp.concatenate([xt, jnp.zeros((1, D), xt.dtype)], axis=0)
    xs = x_pad[slot_token].reshape(n_blocks, EXPERT_BLOCK, D)
    block_expert = jnp.minimum(
        jnp.searchsorted(pend, jnp.arange(n_blocks, dtype=jnp.int32) * EXPERT_BLOCK, side='right'),
        N_EXPERTS - 1)

    def expert_block(args):
        xb, e = args
        h = xb @ w_gate_up[e] + b_gate_up[e]
        g, u = h[:, :D_EXPERT], h[:, D_EXPERT:]
        g = jnp.minimum(g, SWIGLU_LIMIT)
        u = jnp.clip(u, -SWIGLU_LIMIT, SWIGLU_LIMIT)
        glu = g * jax.nn.sigmoid(g * SWIGLU_ALPHA)
        return ((u + 1.0) * glu) @ w_down[e] + b_down[e]

    ys = lax.map(expert_block, (xs, block_expert)).reshape(n_pad, D)
    y = jnp.einsum('tkd,tk->td', ys[dest].reshape(T, TOP_K, D), gates.astype(ys.dtype))
    return y.reshape(B, S, D)


def setup_inputs(seed: int = 0) -> dict:
    key = jax.random.key(seed)
    ks = jax.random.split(key, 24)
    D, L, F, E = D_MODEL, DEPTH, D_EXPERT, N_EXPERTS
    beta = DEEPNORM_BETA

    def nrm(k, shape, scale):
        return jax.random.normal(k, shape, jnp.float32) * scale

    col_scale = jnp.concatenate([
        jnp.ones((2 * FOX_W,), jnp.float32), jnp.full((FOX_W,), beta, jnp.float32),
        jnp.ones((N_FOX + 2 * MOBA_W,), jnp.float32), jnp.full((MOBA_W,), beta, jnp.float32)])
    return {
        "x": nrm(ks[0], (BATCH, SEQ, D), 1.0),
        "mem": nrm(ks[1], (BATCH, N_MEM, D), 1.0),
        "w_in": nrm(ks[2], (L, D, IN_COLS), D ** -0.5) * col_scale,
        "b_forget": 3.0 + nrm(ks[3], (L, N_FOX), 1.0),
        "w_mix_out": nrm(ks[4], (L, D, D), beta * D ** -0.5),
        "rel_bias": nrm(ks[5], (N_BUCKETS, N_MOBA), 0.5),
        "ln1_g": 1.0 + nrm(ks[6], (L, D), 0.02),
        "ln1_b": nrm(ks[7], (L, D), 0.02),
        "w_cq": nrm(ks[8], (L, D, D), D ** -0.5),
        "w_ck": nrm(ks[9], (L, D, D), D ** -0.5),
        "w_cv": nrm(ks[10], (L, D, D), beta * D ** -0.5),
        "w_co": nrm(ks[11], (L, D, D), beta * D ** -0.5),
        "ln2_g": 1.0 + nrm(ks[12], (L, D), 0.02),
        "ln2_b": nrm(ks[13], (L, D), 0.02),
        "w_router": nrm(ks[14], (L, D, E), D ** -0.5),
        "b_router": nrm(ks[15], (L, E), 0.01),
        "w_gate_up": nrm(ks[16], (L, E, D, 2 * F), beta * D ** -0.5),
        "b_gate_up": nrm(ks[17], (L, E, 2 * F), 0.01),
        "w_down": nrm(ks[18], (L, E, F, D), beta * F ** -0.5),
        "b_down": nrm(ks[19], (L, E, D), 0.01),
        "ln3_g": 1.0 + nrm(ks[20], (L, D), 0.02),
        "ln3_b": nrm(ks[21], (L, D), 0.02),
    }


def reference(x, mem, w_in, b_forget, w_mix_out, rel_bias, ln1_g, ln1_b,
              w_cq, w_ck, w_cv, w_co, ln2_g, ln2_b,
              w_router, b_router, w_gate_up, b_gate_up, w_down, b_down,
              ln3_g, ln3_b):
    for l in range(DEPTH):
        h = hybrid_mixer(x, w_in[l], b_forget[l], w_mix_out[l], rel_bias)
        x = layer_norm(DEEPNORM_ALPHA * x + h, ln1_g[l], ln1_b[l])
        h = memory_cross_attention(x, mem, w_cq[l], w_ck[l], w_cv[l], w_co[l])
        x = layer_norm(DEEPNORM_ALPHA * x + h, ln2_g[l], ln2_b[l])
        h = moe_ffn(x, w_router[l], b_router[l], w_gate_up[l], b_gate_up[l],
                    w_down[l], b_down[l])
        x = layer_norm(DEEPNORM_ALPHA * x + h, ln3_g[l], ln3_b[l])
    return x
```

```cpp
#include <hip/hip_runtime.h>
#include <cstdio>
#include <cstdint>
#include <cmath>

#define GAS __attribute__((address_space(1)))
#define LAS __attribute__((address_space(3)))
typedef unsigned short bf16_t;
typedef short bf16x8 __attribute__((ext_vector_type(8)));
typedef float f32x4 __attribute__((ext_vector_type(4)));
typedef float f32x2 __attribute__((ext_vector_type(2)));
typedef float f32x16 __attribute__((ext_vector_type(16)));
typedef unsigned u32x4 __attribute__((ext_vector_type(4)));
typedef unsigned u32x2 __attribute__((ext_vector_type(2)));
typedef short s16x4 __attribute__((ext_vector_type(4)));

constexpr int NB = 16, SEQ = 2048, DM = 1024, NL = 4, T = NB * SEQ;
constexpr int NMEM = 256, TM = NB * NMEM;
constexpr int NE = 32, TOPK = 4, TK = T * TOPK;
constexpr int IN_COLS = 3080, IN_N = 3072;
constexpr int FCOL = 1536;
constexpr float LN_EPS = 1e-5f;
constexpr float DN_ALPHA = 1.681792830507429f;
constexpr float LOG2E = 1.4426950408889634f;
constexpr float C2_ATT = 0.125f * LOG2E;
constexpr float C2_CROSS = 0.0625f * LOG2E;
constexpr int ECAP = 32768;
constexpr int MAXTILES = 544;

__device__ __forceinline__ unsigned cvt_pk_bf16(float lo, float hi) { unsigned r; asm volatile("v_cvt_pk_bf16_f32 %0, %1, %2" : "=v"(r) : "v"(lo), "v"(hi)); return r; }
__device__ __forceinline__ float bf2f(unsigned short b) { return __uint_as_float((unsigned)b << 16); }
#include <hip/hip_bf16.h>
typedef GAS unsigned gu32;
typedef GAS unsigned long long gu64;
#define RLX_AGENT __ATOMIC_RELAXED, __HIP_MEMORY_SCOPE_AGENT
namespace pg8 {
constexpr int BM = 256, BK = 64, HALF = 128, HTB = HALF * BK * 2  , STAGE_BYTES = 8 * HTB, NXCD = 8, WGM = 8;

__host__ __device__ __forceinline__ int lds_byte(int r, int c) { const int st = (r >> 4) * 2 + (c >> 5), rr = r & 15, cc = c & 31, ob = rr * 64 + cc * 2; return st * 1024 + (ob ^ (((ob >> 9) & 1) << 5)); }
__host__ __device__ __forceinline__ void stage_rc(int b, int& R, int& C) { const int st = b / 1024, sb = b % 1024, swz = sb ^ (((sb >> 9) & 1) << 5); R = (st >> 1) * 16 + swz / 64; C = (st & 1) * 32 + (swz % 64) / 2; }
__host__ __device__ __forceinline__ int perm32(int rho) { const int n = rho >> 4, i = rho & 15; return 8 * (i >> 2) + 4 * n + (i & 3); }

struct Unit { long abyte, bbyte; int orow, ocol, aux, grow, gcnt; };
struct Gemm { const bf16_t* A; const bf16_t* Bt; int lda, ldb, K; const int* gtok; };

__device__ __forceinline__ int xcd_chunk(int L, int nwg) { const int q = nwg / NXCD, r = nwg % NXCD, xcd = L % NXCD, off = L / NXCD; return (xcd < r ? xcd * (q + 1) : r * (q + 1) + (xcd - r) * q) + off; }

template <int MODE> struct GridOrder {
    int nM, nN, nwg, G, c, lda, ldb;
    __device__ __forceinline__ void init(int nM_, int nN_, int G_, int c_, int lda_, int ldb_) { nM = nM_; nN = nN_; nwg = nM * nN; G = G_; c = c_; lda = lda_; ldb = ldb_; }
    __device__ __forceinline__ bool next(int i, Unit& u) const {
        const long L = (long)i * G + c; if (L >= nwg) return false;
        const int wgid = xcd_chunk((int)L, nwg);
        const int nig = WGM * nN, gid = wgid / nig, fm = gid * WGM, gsz = (nM - fm) < WGM ? (nM - fm) : WGM;
        const int pm = fm + ((wgid % nig) % gsz), pn = (wgid % nig) / gsz;
        u.orow = pm * BM; u.ocol = pn * BM; u.aux = pn; u.grow = 0; u.gcnt = BM;
        if (MODE == 0) { u.abyte = (long)pm * BM * lda * 2; u.bbyte = (long)pn * BM * ldb * 2; }
        else { const int b = pm >> 3; u.abyte = (long)pm * BM * lda * 2 + pn * 512;
               u.bbyte = (MODE == 1) ? ((long)b * 256 * ldb + pn * 256) * 2 : ((long)pn * 256 * ldb + b * 256) * 2; }
        return true;
    }
};
template <int NPN, bool GATHER> struct MoeOrder {
    const LAS int* tp; const LAS int* cnt; int nwg, G, c;
    __device__ __forceinline__ void init(const LAS int* tp_, const LAS int* cnt_, int G_, int c_) { tp = tp_; cnt = cnt_; G = G_; c = c_; nwg = __builtin_amdgcn_readfirstlane(tp_[32]) * NPN; }
    __device__ __forceinline__ bool next(int i, Unit& u) const {
        const long L = (long)i * G + c; if (L >= nwg) return false;
        const int wgid = xcd_chunk((int)L, nwg);
        int e = 0;
#pragma unroll
        for (int k = 16; k >= 1; k >>= 1) { const int v = __builtin_amdgcn_readfirstlane(tp[e + k]); if (v * NPN <= wgid) e += k; }
        const int t0 = __builtin_amdgcn_readfirstlane(tp[e]), t1 = __builtin_amdgcn_readfirstlane(tp[e + 1]), ce = __builtin_amdgcn_readfirstlane(cnt[e]);
        const int r = wgid - t0 * NPN, nte = t1 - t0, j = r % nte, pn = r / nte;
        u.aux = e; u.grow = e * ECAP + j * BM; u.gcnt = (ce - j * BM) < BM ? (ce - j * BM) : BM;
        u.orow = (t0 + j) * BM; u.ocol = pn;
        u.abyte = GATHER ? 0 : (long)(t0 + j) * BM * DM * 2;
        u.bbyte = (long)(e * NPN + pn) * BM * DM * 2;
        return true;
    }
};

struct EpiCtx { int wr, wc, fr, fq, wid, lane; LAS unsigned char* xch; };

struct EpiQKV {
    static constexpr bool PERM = true;
    bf16_t *Q, *K, *V; float* kpart;
    __device__ __forceinline__ void operator()(const f32x4 (&acc)[2][2][4][2], const Unit& u, const EpiCtx& c) const {
        const int pn = u.aux, ts = (pn >> 1) % 3, grp = pn / 6;
        bf16_t* base = (ts == 0) ? Q : ((ts == 1) ? K : V);
        const float sc = (ts == 0) ? C2_ATT : 1.f;
        const int row0 = u.orow + c.wr * 64 + c.fr, col0 = grp * 512 + (pn & 1) * 256 + c.wc * 32 + 8 * c.fq;
#pragma unroll
        for (int ai = 0; ai < 2; ++ai)
#pragma unroll
            for (int m = 0; m < 4; ++m) { bf16_t* rowp = base + (size_t)(row0 + ai * HALF + m * 16) * DM + col0;
#pragma unroll
                for (int bj = 0; bj < 2; ++bj) { const f32x4 v0 = acc[ai][bj][m][0] * sc, v1 = acc[ai][bj][m][1] * sc;
                    u32x4 w; w.x = cvt_pk_bf16(v0[0], v0[1]); w.y = cvt_pk_bf16(v0[2], v0[3]); w.z = cvt_pk_bf16(v1[0], v1[1]); w.w = cvt_pk_bf16(v1[2], v1[3]);
                    *(u32x4*)(rowp + bj * HALF) = w; } }
        if (pn == 8 || pn == 9) {
#pragma unroll
            for (int bj = 0; bj < 2; ++bj)
#pragma unroll
                for (int n = 0; n < 2; ++n) { f32x4 s = (f32x4){0.f, 0.f, 0.f, 0.f};
#pragma unroll
                    for (int ai = 0; ai < 2; ++ai)
#pragma unroll
                        for (int m = 0; m < 4; ++m) s += acc[ai][bj][m][n];
#pragma unroll
                    for (int o = 1; o < 16; o <<= 1) { s[0] += __shfl_xor(s[0], o); s[1] += __shfl_xor(s[1], o); s[2] += __shfl_xor(s[2], o); s[3] += __shfl_xor(s[3], o); }
                    if (c.fr == 0) *(f32x4*)(kpart + (size_t)((u.orow >> 8) * 2 + c.wr) * 512 + (pn - 8) * 256 + bj * HALF + c.wc * 32 + 8 * c.fq + 4 * n) = s; }
        }
    }
};
struct EpiResid {
    static constexpr bool PERM = false;
    const float* res; float* out;
    __device__ __forceinline__ void operator()(const f32x4 (&acc)[2][2][4][2], const Unit& u, const EpiCtx& c) const {
        const int row0 = u.orow + c.wr * 64 + c.fr, col0 = u.ocol + c.wc * 32 + 4 * c.fq;
#pragma unroll
        for (int ai = 0; ai < 2; ++ai)
#pragma unroll
            for (int m = 0; m < 4; ++m) { const size_t off = (size_t)(row0 + ai * HALF + m * 16) * DM + col0;
#pragma unroll
                for (int bj = 0; bj < 2; ++bj)
#pragma unroll
                    for (int n = 0; n < 2; ++n) { const f32x4 r = *(const f32x4*)(res + off + bj * HALF + n * 16); *(f32x4*)(out + off + bj * HALF + n * 16) = r * DN_ALPHA + acc[ai][bj][m][n]; } }
    }
};
struct EpiBf16S {
    static constexpr bool PERM = true;
    bf16_t* O; int ldc; float scale; const float* bias; int bstride; int cmul;
    __device__ __forceinline__ void operator()(const f32x4 (&acc)[2][2][4][2], const Unit& u, const EpiCtx& c) const {
        const int row0 = u.orow + c.wr * 64 + c.fr, col0 = u.ocol * cmul + c.wc * 32 + 8 * c.fq;
        f32x4 bv[2][2];
#pragma unroll
        for (int bj = 0; bj < 2; ++bj)
#pragma unroll
            for (int n = 0; n < 2; ++n) bv[bj][n] = bias ? *(const f32x4*)(bias + (size_t)u.aux * bstride + col0 + bj * HALF + 4 * n) : (f32x4){0.f, 0.f, 0.f, 0.f};
#pragma unroll
        for (int ai = 0; ai < 2; ++ai)
#pragma unroll
            for (int m = 0; m < 4; ++m) { bf16_t* rowp = O + (size_t)(row0 + ai * HALF + m * 16) * ldc + col0;
#pragma unroll
                for (int bj = 0; bj < 2; ++bj) { const f32x4 v0 = (acc[ai][bj][m][0] + bv[bj][0]) * scale, v1 = (acc[ai][bj][m][1] + bv[bj][1]) * scale;
                    u32x4 w; w.x = cvt_pk_bf16(v0[0], v0[1]); w.y = cvt_pk_bf16(v0[2], v0[3]); w.z = cvt_pk_bf16(v1[0], v1[1]); w.w = cvt_pk_bf16(v1[2], v1[3]);
                    *(u32x4*)(rowp + bj * HALF) = w; } }
    }
};
struct EpiSwiglu {
    static constexpr bool PERM = true;
    bf16_t* O; const float* bias;
    __device__ __forceinline__ void operator()(const f32x4 (&acc)[2][2][4][2], const Unit& u, const EpiCtx& c) const {
        const int row0 = u.orow + c.wr * 64 + c.fr, col0 = u.ocol * HALF + c.wc * 32 + 8 * c.fq;
        const float* bp = bias + (size_t)u.aux * 2048 + col0;
        f32x4 bg[2], bu[2];
#pragma unroll
        for (int n = 0; n < 2; ++n) { bg[n] = *(const f32x4*)(bp + 4 * n); bu[n] = *(const f32x4*)(bp + 1024 + 4 * n); }
#pragma unroll
        for (int ai = 0; ai < 2; ++ai)
#pragma unroll
            for (int m = 0; m < 4; ++m) { float o[8];
#pragma unroll
                for (int n = 0; n < 2; ++n)
#pragma unroll
                    for (int i = 0; i < 4; ++i) { float gv = acc[ai][0][m][n][i] + bg[n][i], uv = acc[ai][1][m][n][i] + bu[n][i];
                        gv = fminf(gv, 7.0f); uv = fminf(fmaxf(uv, -7.0f), 7.0f);
                        const float sg = __builtin_amdgcn_rcpf(1.0f + __builtin_amdgcn_exp2f(gv * (-1.702f * LOG2E)));
                        o[n * 4 + i] = (uv + 1.0f) * (gv * sg); }
                u32x4 w; w.x = cvt_pk_bf16(o[0], o[1]); w.y = cvt_pk_bf16(o[2], o[3]); w.z = cvt_pk_bf16(o[4], o[5]); w.w = cvt_pk_bf16(o[6], o[7]);
                *(u32x4*)(O + (size_t)(row0 + ai * HALF + m * 16) * DM + col0) = w; }
    }
};
struct EpiSoftmax {
    static constexpr bool PERM = true;
    bf16_t* O;
    __device__ __forceinline__ void operator()(f32x4 (&acc)[2][2][4][2], const Unit& u, const EpiCtx& c0) const {
        EpiCtx c = c0; asm volatile("" : "+v"(c.fr), "+v"(c.fq));
        LAS float* MX = (LAS float*)c.xch;
        LAS float* SM = (LAS float*)(c.xch + 4096);
#pragma unroll
        for (int ai = 0; ai < 2; ++ai)
#pragma unroll
            for (int m = 0; m < 4; ++m) { float mx = -INFINITY;
#pragma unroll
                for (int bj = 0; bj < 2; ++bj)
#pragma unroll
                    for (int n = 0; n < 2; ++n) { const f32x4 x = acc[ai][bj][m][n]; mx = fmaxf(mx, fmaxf(fmaxf(x[0], x[1]), fmaxf(x[2], x[3]))); }
                mx = fmaxf(mx, __shfl_xor(mx, 16)); mx = fmaxf(mx, __shfl_xor(mx, 32));
                if (c.fq == 0) MX[(ai * HALF + c.wr * 64 + m * 16 + c.fr) * 4 + c.wc] = mx; }
        asm volatile("s_waitcnt lgkmcnt(0)" ::: "memory"); __builtin_amdgcn_s_barrier(); asm volatile("" ::: "memory");
#pragma unroll
        for (int ai = 0; ai < 2; ++ai)
#pragma unroll
            for (int m = 0; m < 4; ++m) { const int r = ai * HALF + c.wr * 64 + m * 16 + c.fr; const f32x4 mm = *(const LAS f32x4*)(MX + r * 4);
                const float mx = fmaxf(fmaxf(mm[0], mm[1]), fmaxf(mm[2], mm[3])); float s = 0.f;
#pragma unroll
                for (int bj = 0; bj < 2; ++bj)
#pragma unroll
                    for (int n = 0; n < 2; ++n) { f32x4 x = acc[ai][bj][m][n];
                        x[0] = __builtin_amdgcn_exp2f(x[0] - mx); x[1] = __builtin_amdgcn_exp2f(x[1] - mx); x[2] = __builtin_amdgcn_exp2f(x[2] - mx); x[3] = __builtin_amdgcn_exp2f(x[3] - mx);
                        s += (x[0] + x[1]) + (x[2] + x[3]); acc[ai][bj][m][n] = x; }
                s += __shfl_xor(s, 16); s += __shfl_xor(s, 32);
                if (c.fq == 0) SM[r * 4 + c.wc] = s; __builtin_amdgcn_sched_barrier(0); }
        asm volatile("s_waitcnt lgkmcnt(0)" ::: "memory"); __builtin_amdgcn_s_barrier(); asm volatile("" ::: "memory");
        const int row0 = u.orow + c.wr * 64 + c.fr, col0 = u.ocol + c.wc * 32 + 8 * c.fq;
#pragma unroll
        for (int ai = 0; ai < 2; ++ai)
#pragma unroll
            for (int m = 0; m < 4; ++m) { const int r = ai * HALF + c.wr * 64 + m * 16 + c.fr; const f32x4 ss = *(const LAS f32x4*)(SM + r * 4);
                const float rl = 1.0f / ((ss[0] + ss[1]) + (ss[2] + ss[3]));
                bf16_t* rowp = O + (size_t)(row0 + ai * HALF + m * 16) * DM + col0;
#pragma unroll
                for (int bj = 0; bj < 2; ++bj) { const f32x4 v0 = acc[ai][bj][m][0] * rl, v1 = acc[ai][bj][m][1] * rl;
                    u32x4 w; w.x = cvt_pk_bf16(v0[0], v0[1]); w.y = cvt_pk_bf16(v0[2], v0[3]); w.z = cvt_pk_bf16(v1[0], v1[1]); w.w = cvt_pk_bf16(v1[2], v1[3]);
                    *(u32x4*)(rowp + bj * HALF) = w; } __builtin_amdgcn_sched_barrier(0); }
    }
};

template <class Epi, class Sched, bool GATHER, bool ALIGN_EPI>
__device__ __forceinline__ void gemm_phase(int tid, LAS unsigned char* lds, LAS unsigned char* xch, const Gemm g, const Sched& S, const Epi& E) {
    const int wid = __builtin_amdgcn_readfirstlane(tid >> 6), lane = tid & 63, wr = wid >> 2, wc = wid & 3, fr = lane & 15, fq = lane >> 4;
    int Kv = g.K; asm volatile("" : "+s"(Kv));
    const int nt = Kv / BK;
    EpiCtx ctx; ctx.wr = wr; ctx.wc = wc; ctx.fr = fr; ctx.fq = fq; ctx.wid = wid; ctx.lane = lane; ctx.xch = xch;
    unsigned oB[2], oAc[2][2], oAn[2][2];
#pragma unroll
    for (int i = 0; i < 2; ++i) { int R, C; stage_rc(tid * 16 + i * 8192, R, C); const int Rb = Epi::PERM ? ((R & ~31) + perm32(R & 31)) : R;
        oB[i] = (unsigned)(Rb * g.ldb + C) * 2u;
        oAc[0][i] = (unsigned)(R * g.lda + C) * 2u; oAc[1][i] = oAc[0][i] + (unsigned)(HALF * g.lda * 2); oAn[0][i] = oAc[0][i]; oAn[1][i] = oAc[1][i]; }
    const size_t kstep = (size_t)(BK * 2);
    const size_t hstepB = (size_t)HALF * g.ldb * 2;
    const unsigned ldsw = (unsigned)wid * 1024u;
    const int aoff = lds_byte(wr * 64 + fr, fq * 8), boff = lds_byte(wc * 32 + fr, fq * 8);
#define PG8_SA(b, h) (((b) * 2 + (h)) * HTB)
#define PG8_SB(b, h) ((4 + (b) * 2 + (h)) * HTB)
#define PG8_STAGE(bufoff, gbase, o0, o1) do { \
        __builtin_amdgcn_global_load_lds((const unsigned*)((const char*)(gbase) + (o0)), (LAS unsigned*)(lds + (bufoff) + ldsw), 16, 0, 0); \
        __builtin_amdgcn_global_load_lds((const unsigned*)((const char*)(gbase) + (o1)), (LAS unsigned*)(lds + (bufoff) + ldsw + 8192), 16, 0, 0); } while (0)
#define PG8_STAGE_B(bufoff, gbase) PG8_STAGE(bufoff, gbase, oB[0], oB[1])
#define PG8_LDA(dst, b, h) do { _Pragma("unroll") for (int m = 0; m < 4; ++m) _Pragma("unroll") for (int k = 0; k < 2; ++k) dst[m][k] = *(const LAS bf16x8*)(lds + PG8_SA(b, h) + aoff + m * 2048 + k * 1024); } while (0)
#define PG8_LDB(dst, b, h) do { _Pragma("unroll") for (int n = 0; n < 2; ++n) _Pragma("unroll") for (int k = 0; k < 2; ++k) dst[n][k] = *(const LAS bf16x8*)(lds + PG8_SB(b, h) + boff + n * 2048 + k * 1024); } while (0)
#define PG8_MMA(ai, bj, At, Bt) do { __builtin_amdgcn_s_setprio(1); _Pragma("unroll") for (int m = 0; m < 4; ++m) _Pragma("unroll") for (int n = 0; n < 2; ++n) _Pragma("unroll") for (int k = 0; k < 2; ++k) \
        acc[ai][bj][m][n] = __builtin_amdgcn_mfma_f32_16x16x32_bf16(Bt[n][k], At[m][k], acc[ai][bj][m][n], 0, 0, 0); __builtin_amdgcn_s_setprio(0); } while (0)
#define PG8_WAIT_V(n) asm volatile("s_waitcnt vmcnt(" #n ")" ::: "memory")
#define PG8_WAIT_L(n) asm volatile("s_waitcnt lgkmcnt(" #n ")" ::: "memory")
#define PG8_BAR __builtin_amdgcn_s_barrier()
#define PG8_SCHED __builtin_amdgcn_sched_barrier(0)
#define PG8_TOK_LOAD(U, tk) do { int t_ = tid; asm volatile("" : "+v"(t_)); _Pragma("unroll") for (int i = 0; i < 2; ++i) { int R_, C_; stage_rc(t_ * 16 + i * 8192, R_, C_); _Pragma("unroll") for (int h = 0; h < 2; ++h) { \
        const int r_ = h * HALF + R_; tk[h][i] = (r_ < (U).gcnt) ? ((const GAS int*)g.gtok)[(U).grow + r_] : 0; } } } while (0)
#define PG8_TOK_OFF(tk, set) do { int t_ = tid; asm volatile("" : "+v"(t_)); _Pragma("unroll") for (int i = 0; i < 2; ++i) { int R_, C_; stage_rc(t_ * 16 + i * 8192, R_, C_); _Pragma("unroll") for (int h = 0; h < 2; ++h) { \
        set[h][i] = (unsigned)(tk[h][i] * g.lda + C_) * 2u; asm volatile("" : "+v"(set[h][i])); } } } while (0)
    Unit cur, nxt, nn; int ui = 0;
    if (!S.next(0, cur)) return;
    bool has_next = S.next(1, nxt);
    if constexpr (GATHER) {
        int tk[2][2]; PG8_TOK_LOAD(cur, tk); PG8_TOK_OFF(tk, oAc);
        if (has_next) { PG8_TOK_LOAD(nxt, tk); PG8_TOK_OFF(tk, oAn); }
        else {
#pragma unroll
            for (int h = 0; h < 2; ++h)
#pragma unroll
                for (int i = 0; i < 2; ++i) oAn[h][i] = oAc[h][i]; }
    }
    f32x4 acc[2][2][4][2];
#pragma unroll
    for (int a = 0; a < 2; ++a)
#pragma unroll
        for (int b = 0; b < 2; ++b)
#pragma unroll
            for (int m = 0; m < 4; ++m)
#pragma unroll
                for (int n = 0; n < 2; ++n) acc[a][b][m][n] = (f32x4){0.f, 0.f, 0.f, 0.f};
    bf16x8 At[4][2], B0[2][2], B1[2][2];
    const char* cA = (const char*)g.A + cur.abyte; const char* cB = (const char*)g.Bt + cur.bbyte;
    PG8_STAGE_B(PG8_SB(0, 0), cB); PG8_STAGE_B(PG8_SB(0, 1), cB + hstepB); PG8_STAGE(PG8_SA(0, 0), cA, oAc[0][0], oAc[0][1]); PG8_STAGE(PG8_SA(0, 1), cA, oAc[1][0], oAc[1][1]);
    if (wr == 1) PG8_BAR;
    PG8_WAIT_V(2); PG8_BAR;
    PG8_STAGE_B(PG8_SB(1, 0), cB + kstep); PG8_STAGE(PG8_SA(1, 0), cA + kstep, oAc[0][0], oAc[0][1]); PG8_STAGE_B(PG8_SB(1, 1), cB + hstepB + kstep);
    PG8_WAIT_V(6); PG8_BAR;
    for (;;) {
        bool has_nn = false;
        if (has_next) has_nn = S.next(ui + 2, nn);
        int tkp[2][2];
        if constexpr (GATHER) { if (has_nn) { PG8_TOK_LOAD(nn, tkp); } }
        const char* nA = has_next ? (const char*)g.A + nxt.abyte : cA; const char* nB = has_next ? (const char*)g.Bt + nxt.bbyte : cB;
        for (int t = 0; t < nt; t += 2) {
            const bool last = (t == nt - 2);
            const char* a1 = cA + (size_t)(t + 1) * kstep;
            const char* a2 = last ? nA : cA + (size_t)(t + 2) * kstep; const char* b2 = last ? nB : cB + (size_t)(t + 2) * kstep;
            const char* a3 = a2 + kstep; const char* b3 = b2 + kstep;
            unsigned o2[2][2];
#pragma unroll
            for (int h = 0; h < 2; ++h)
#pragma unroll
                for (int i = 0; i < 2; ++i) o2[h][i] = GATHER ? (last ? oAn[h][i] : oAc[h][i]) : oAc[h][i];
            PG8_LDB(B0, 0, 0); PG8_LDB(B1, 0, 1); PG8_SCHED; PG8_LDA(At, 0, 0); PG8_STAGE(PG8_SA(1, 1), a1, oAc[1][0], oAc[1][1]);
            PG8_WAIT_V(8); PG8_WAIT_L(0); PG8_BAR; PG8_MMA(0, 0, At, B0); PG8_MMA(0, 1, At, B1); PG8_BAR; PG8_SCHED;
            PG8_LDA(At, 0, 1); PG8_STAGE_B(PG8_SB(0, 0), b2); PG8_STAGE_B(PG8_SB(0, 1), b2 + hstepB); PG8_STAGE(PG8_SA(0, 0), a2, o2[0][0], o2[0][1]);
            PG8_WAIT_V(8); PG8_WAIT_L(0); PG8_BAR; PG8_MMA(1, 0, At, B0); PG8_MMA(1, 1, At, B1); PG8_BAR; PG8_SCHED;
            PG8_LDB(B0, 1, 0); PG8_LDB(B1, 1, 1); PG8_SCHED; PG8_LDA(At, 1, 0); PG8_STAGE(PG8_SA(0, 1), a2, o2[1][0], o2[1][1]);
            PG8_WAIT_V(8); PG8_WAIT_L(0); PG8_BAR; PG8_MMA(0, 0, At, B0); PG8_MMA(0, 1, At, B1); PG8_BAR; PG8_SCHED;
            PG8_LDA(At, 1, 1); PG8_STAGE_B(PG8_SB(1, 0), b3); PG8_STAGE_B(PG8_SB(1, 1), b3 + hstepB); PG8_STAGE(PG8_SA(1, 0), a3, o2[0][0], o2[0][1]);
            PG8_WAIT_V(8); PG8_WAIT_L(0); PG8_BAR; PG8_MMA(1, 0, At, B0); PG8_MMA(1, 1, At, B1); PG8_BAR; PG8_SCHED;
        }
        if constexpr (ALIGN_EPI) { if (wr == 0) PG8_BAR; }
        E(acc, cur, ctx);
        if (!has_next) break;
#pragma unroll
        for (int a = 0; a < 2; ++a)
#pragma unroll
            for (int b = 0; b < 2; ++b)
#pragma unroll
                for (int m = 0; m < 4; ++m)
#pragma unroll
                    for (int n = 0; n < 2; ++n) acc[a][b][m][n] = (f32x4){0.f, 0.f, 0.f, 0.f};
        cur = nxt; cA = nA; cB = nB; ++ui; nxt = nn; has_next = has_nn;
        if constexpr (GATHER) {
#pragma unroll
            for (int h = 0; h < 2; ++h)
#pragma unroll
                for (int i = 0; i < 2; ++i) oAc[h][i] = oAn[h][i];
            if (has_next) { PG8_TOK_OFF(tkp, oAn); }
        }
        if constexpr (ALIGN_EPI) { if (wr == 1) PG8_BAR; }
    }
    PG8_WAIT_V(0);
    if constexpr (!ALIGN_EPI) { if (wr == 0) PG8_BAR; }
    PG8_BAR;
#undef PG8_SA
#undef PG8_SB
#undef PG8_STAGE
#undef PG8_STAGE_B
#undef PG8_LDA
#undef PG8_LDB
#undef PG8_MMA
#undef PG8_WAIT_V
#undef PG8_WAIT_L
#undef PG8_BAR
#undef PG8_SCHED
#undef PG8_TOK_LOAD
#undef PG8_TOK_OFF
}
}
namespace attn_body {
using bf16=__hip_bfloat16;
using bf16x8=__attribute__((ext_vector_type(8)))short;
using s16x4=__attribute__((ext_vector_type(4)))short;
using f32x16=__attribute__((ext_vector_type(16)))float;
using u32x4=__attribute__((ext_vector_type(4)))unsigned;
constexpr int BATCH=16,NHEAD=16,SEQ=2048,D=64,DM=NHEAD*D;
constexpr int NW=8,QBLK=32,QB=QBLK*NW,KVBLK=64,NQB=SEQ/QB;
constexpr int ATTN_PITCH=DM, ATTN_UNIT_ROWS=QB;
__device__ __forceinline__ int crow(int r,int hi){return (r&3)+8*(r>>2)+4*hi;}
#define SBAR() __builtin_amdgcn_sched_barrier(0)
__device__ __forceinline__ void cmask(f32x16&p0,f32x16&p1,int jb,int qrel,int hi){
  const float NEG=-INFINITY; const int qd=qrel-64*jb-4*hi;
  #pragma unroll
  for(int r=0;r<16;++r){const int c=(r&3)+8*(r>>2); if(c>qd)p0[r]=NEG; if(c+32>qd)p1[r]=NEG;}
}

constexpr int NSLOT=3, SLOTB=8192;
constexpr int LDS_K=0, LDS_V=NSLOT*SLOTB, LDS_WS=2*NSLOT*SLOTB, LDS_OST=LDS_WS+NW*64*4, LDS_TAB=LDS_OST+NW*4096, LDS_BYTES=LDS_TAB+8192;
constexpr float C2=0.125f*1.4426950408889634f;
__device__ __forceinline__ void glds16(const void*gsrc,unsigned lds_dst){unsigned keep;
  asm volatile("s_mov_b32 %0, m0\n\ts_mov_b32 m0, %2\n\ts_nop 0\n\tglobal_load_lds_dwordx4 %1, off\n\ts_mov_b32 m0, %0":"=&s"(keep):"v"(gsrc),"s"(lds_dst):"memory");}
__device__ __forceinline__ float max3f(float a,float b,float c){float r;asm("v_max3_f32 %0, %1, %2, %3":"=v"(r):"v"(a),"v"(b),"v"(c));return r;}
__device__ __forceinline__ float max2f(float a,float b){float r;asm("v_max_f32_e32 %0, %1, %2":"=v"(r):"v"(a),"v"(b));return r;}
__device__ __forceinline__ float fadd_s(float a,float b){float r;asm("v_add_f32_e32 %0, %1, %2":"=v"(r):"v"(a),"v"(b));return r;}
__device__ __forceinline__ float fsub_s(float a,float b){float r;asm("v_sub_f32_e32 %0, %1, %2":"=v"(r):"v"(a),"v"(b));return r;}
typedef float f32x2_t __attribute__((ext_vector_type(2))); typedef float f32x4_t __attribute__((ext_vector_type(4))); typedef __bf16 bf16x2_t __attribute__((ext_vector_type(2)));
__device__ __forceinline__ unsigned cvtpk_s(float lo,float hi){f32x2_t v={lo,hi};bf16x2_t b=__builtin_convertvector(v,bf16x2_t);return __builtin_bit_cast(unsigned,b);}
#define WAIT_BAR(N) asm volatile("s_waitcnt vmcnt(" #N ") lgkmcnt(0)\n\ts_barrier":::"memory")

__device__ __forceinline__ void qkt(f32x16&p0,f32x16&p1,const char*Kslot,const bf16x8*qr,int r32,int hi){
  const char*kb=Kslot+hi*1024+r32*16;
  #pragma unroll
  for(int d0=0;d0<4;++d0){
    const bf16x8 b0=*reinterpret_cast<const bf16x8*>(kb+d0*2048);
    const bf16x8 b1=*reinterpret_cast<const bf16x8*>(kb+d0*2048+512);
    {p0=__builtin_amdgcn_mfma_f32_32x32x16_bf16(b0,qr[d0],p0,0,0,0);p1=__builtin_amdgcn_mfma_f32_32x32x16_bf16(b1,qr[d0],p1,0,0,0);}}
}
typedef __attribute__((address_space(3))) const char* lds_cptr;
typedef short v4i16_t __attribute__((ext_vector_type(4)));
__device__ __forceinline__ void kload8(bf16x8*kf,lds_cptr kp){
  kf[0]=*(const __attribute__((address_space(3))) bf16x8*)(kp);      kf[1]=*(const __attribute__((address_space(3))) bf16x8*)(kp+512);
  kf[2]=*(const __attribute__((address_space(3))) bf16x8*)(kp+2048); kf[3]=*(const __attribute__((address_space(3))) bf16x8*)(kp+2560);
  kf[4]=*(const __attribute__((address_space(3))) bf16x8*)(kp+4096); kf[5]=*(const __attribute__((address_space(3))) bf16x8*)(kp+4608);
  kf[6]=*(const __attribute__((address_space(3))) bf16x8*)(kp+6144); kf[7]=*(const __attribute__((address_space(3))) bf16x8*)(kp+6656);
}
__device__ __forceinline__ void kload2(bf16x8*kf,lds_cptr kp,int j){ kf[2*j]=*(const __attribute__((address_space(3))) bf16x8*)(kp+j*2048); kf[2*j+1]=*(const __attribute__((address_space(3))) bf16x8*)(kp+j*2048+512); }
__device__ __forceinline__ s16x4 vtr(lds_cptr p){ return __builtin_bit_cast(s16x4,__builtin_amdgcn_ds_read_tr16_b64_v4i16((__attribute__((address_space(3))) v4i16_t*)p)); }
__device__ __forceinline__ float rowmax(const f32x16&p0,const f32x16&p1){
  float a=max3f(p0[0],p0[1],p1[0]),b=max3f(p0[2],p0[3],p1[1]);a=max3f(a,p1[2],p1[3]);
  #pragma unroll
  for(int r=4;r<16;r+=4){a=max3f(a,p0[r],p0[r+1]);b=max3f(b,p0[r+2],p0[r+3]);a=max3f(a,p1[r],p1[r+1]);b=max3f(b,p1[r+2],p1[r+3]);}
  const float m=max2f(a,b);
  auto rr=__builtin_amdgcn_permlane32_swap(__float_as_uint(m),__float_as_uint(m),false,false);
  return max2f(__uint_as_float(rr[0]),__uint_as_float(rr[1]));
}
__device__ __forceinline__ void pv(f32x16*o,int vb,bf16x8 pa0,bf16x8 pa1,bf16x8 pa2,bf16x8 pa3){
  #pragma unroll
  for(int d0=0;d0<2;++d0){s16x4 lo[4],hi[4];
    #pragma unroll
    for(int ks=0;ks<4;++ks){
      asm volatile("ds_read_b64_tr_b16 %0,%1 offset:%c2":"=&v"(lo[ks]):"v"(vb),"i"(d0*4096+ks*1024):"memory");
      asm volatile("ds_read_b64_tr_b16 %0,%1 offset:%c2":"=&v"(hi[ks]):"v"(vb),"i"(d0*4096+ks*1024+512):"memory");}
    asm volatile("s_waitcnt lgkmcnt(0)":::"memory");SBAR();
    #define PK(k) (bf16x8){lo[k][0],lo[k][1],lo[k][2],lo[k][3],hi[k][0],hi[k][1],hi[k][2],hi[k][3]}
    o[d0]=__builtin_amdgcn_mfma_f32_32x32x16_bf16(pa0,PK(0),o[d0],0,0,0);
    o[d0]=__builtin_amdgcn_mfma_f32_32x32x16_bf16(pa1,PK(1),o[d0],0,0,0);
    o[d0]=__builtin_amdgcn_mfma_f32_32x32x16_bf16(pa2,PK(2),o[d0],0,0,0);
    o[d0]=__builtin_amdgcn_mfma_f32_32x32x16_bf16(pa3,PK(3),o[d0],0,0,0);
    #undef PK
  }
}

#ifndef ATTN_STORE16
#define ATTN_STORE16(p,v) (*(u32x4*)(p)=(v))
#endif
struct AttnExtra { const float* kbias; const float* kpart; const float* relb; };
template<int THRL,int MODE> __device__ __forceinline__ void attn_unit(int b,int h,int qb,const bf16*Q,const bf16*__restrict__ K,const bf16*__restrict__ V,bf16*O,char*shm,const AttnExtra&X,const int tid){
  const int lane=tid&63,r32=lane&31,hi=lane>>5; const int wid=__builtin_amdgcn_readfirstlane(tid>>6);
  const long rowbase=(long)b*SEQ; const int q0=qb*QB;
  const bf16*Qw=Q+(rowbase+q0+wid*QBLK)*DM+h*D;
  const bf16*Kh=K+rowbase*DM+h*D,*Vh=V+rowbase*DM+h*D;
  const unsigned lds0=(unsigned)(uintptr_t)shm;
  float*wsf=(float*)(shm+LDS_WS)+wid*64;
  const bf16*ksrc=Kh+(long)lane*DM+wid*8;
  const bf16*vsrc=Vh+(long)(16*(wid&3)+(lane>>2))*DM+(wid>>2)*32+(lane&3)*8;
  const unsigned kdst=lds0+LDS_K+wid*1024, vdst=lds0+LDS_V+wid*1024;
  #define DMA_K(t,slot) glds16(ksrc+(long)(t)*KVBLK*DM,(unsigned)__builtin_amdgcn_readfirstlane(kdst+(slot)))
  #define DMA_V(t,slot) glds16(vsrc+(long)(t)*KVBLK*DM,(unsigned)__builtin_amdgcn_readfirstlane(vdst+(slot)))
  const int vb0=(int)(lds0+LDS_V)+((lane>>4)&1)*32+(lane&3)*8+(4*hi+((lane&15)>>2))*64;
  const char*Kbase=shm+LDS_K; bf16x8 kf[8];
  const lds_cptr shm3=(lds_cptr)shm; const lds_cptr kp0=shm3+LDS_K+hi*1024+r32*16; const lds_cptr vp0=shm3+LDS_V+((lane>>4)&1)*32+(lane&3)*8+(4*hi+((lane&15)>>2))*64;
  const int NT=(q0+QB)/KVBLK;
  const lds_cptr tab3=(lds_cptr)shm+LDS_TAB;
  { int tq_=tid; asm volatile("":"+v"(tq_)); __attribute__((address_space(3))) float* tabw=(__attribute__((address_space(3))) float*)((__attribute__((address_space(3))) char*)shm+LDS_TAB);
    if(MODE==0){ const f32x4_t kv=*reinterpret_cast<const f32x4_t*>(X.kbias+tq_*4); *reinterpret_cast<__attribute__((address_space(3))) f32x4_t*>(tabw+tq_*4)=kv; }
    else{ const int hm=h-8; { const int j=tq_>>6,d=tq_&63; const float*kp=X.kpart+(long)((b*8+j)*2)*512+hm*64+d; tabw[j*64+d]=(kp[0]+kp[512])*(1.0f/256.0f); }
      { const int tv=tq_; const int n=tv-256; float val=0.f;
        if(n>=0&&n<113){ int bk=n; if(n>=16){ bk=16+(n>=19)+(n>=21)+(n>=24)+(n>=27)+(n>=31)+(n>=35)+(n>=40)+(n>=46)+(n>=52)+(n>=59)+(n>=67)+(n>=77)+(n>=87)+(n>=99); }
          val=(X.relb[bk*8+hm]-X.relb[31*8+hm])*1.4426950408889634f; }
        tabw[512+tv]=val; } } }
  DMA_K(0,0);DMA_V(0,0);DMA_K(1,SLOTB);
  bf16x8 qr[4];
  { int lq_=lane; asm volatile("":"+v"(lq_)); const int rq_=lq_&31,hq_=lq_>>5;
  #pragma unroll
  for(int d0=0;d0<4;++d0)qr[d0]=*reinterpret_cast<const bf16x8*>(&Qw[(long)rq_*DM+d0*16+hq_*8]); }
  float mhat=0.f,l_reg=0.f;f32x16 o[2];o[0]=f32x16{};o[1]=f32x16{};
  const int qrel=wid*QBLK+r32;
  unsigned selmask=0u;
  #define CINIT(C0,C1,t) do{ const int t_=(t); \
    if(MODE==0){ const lds_cptr kbp_=tab3+(64*t_+4*hi)*4; \
      _Pragma("unroll") for(int j_=0;j_<4;++j_){ const f32x4_t a_=*(const __attribute__((address_space(3))) f32x4_t*)(kbp_+32*j_); const f32x4_t b_=*(const __attribute__((address_space(3))) f32x4_t*)(kbp_+128+32*j_); \
        _Pragma("unroll") for(int i_=0;i_<4;++i_){ C0[4*j_+i_]=a_[i_]-mhat; C1[4*j_+i_]=b_[i_]-mhat; } } } \
    else{ const int blk_=t_>>2; const bool keep_=(blk_>=qb)||(((selmask>>blk_)&1u)!=0u); const float c_=keep_?-mhat:-INFINITY; \
      _Pragma("unroll") for(int r_=0;r_<16;++r_){C0[r_]=c_;C1[r_]=c_;} } }while(0)
  #define TMASK(P0,P1,t) do{ const int t_=(t); \
    if(MODE==1){ \
      if(64*t_+176>q0+32*wid){ const int db_=(q0-64*t_)+qrel-4*hi; \
        const lds_cptr tbp_=tab3+2048+4*(db_+256-63); \
        _Pragma("unroll") for(int r_=0;r_<16;++r_){ const int ko_=(r_&3)+8*(r_>>2); \
          P0[r_]+=*(const __attribute__((address_space(3))) float*)(tbp_+4*(63-ko_)); P1[r_]+=*(const __attribute__((address_space(3))) float*)(tbp_+4*(31-ko_)); } } } \
    { const int jb_=t_-(NT-4); if(jb_>=0)cmask(P0,P1,jb_,qrel,hi); } }while(0)
  #define CMASK(P0,P1,t) TMASK(P0,P1,t)
  bool resc=false;
  #define START(P0,P1) do{ const float rm=rowmax(P0,P1); resc=false; \
    { const float dl=(rm>-INFINITY)?rm:0.f; mhat=fadd_s(mhat,dl); \
      _Pragma("unroll") for(int r=0;r<16;++r){P0[r]=fsub_s(P0[r],dl);P1[r]=fsub_s(P1[r],dl);} \
    } \
    _Pragma("unroll") for(int r=0;r<16;++r)P0[r]=__builtin_amdgcn_exp2f(P0[r]); }while(0)
  #define RESC() do{ if(resc){ asm volatile("s_waitcnt lgkmcnt(0)":::"memory"); \
      _Pragma("unroll") for(int d_=0;d_<2;++d_) _Pragma("unroll") for(int r=0;r<16;++r)o[d_][r]*=wsf[crow(r,hi)]; } }while(0)
  f32x16 pA0,pA1,pB0,pB1;
  int sl_prev=0,sl_cur=0,sl_next=SLOTB;
  #define ROT() do{sl_prev=sl_cur;sl_cur=sl_next;sl_next=(sl_next==(NSLOT-1)*SLOTB)?0:sl_next+SLOTB;}while(0)
  DMA_K(2,2*SLOTB);
  WAIT_BAR(3);
  if(MODE==1){
    float gt[7];
    #pragma unroll
    for(int j=0;j<7;++j){ float s=0.f;
      #pragma unroll
      for(int d0=0;d0<4;++d0){ const f32x4_t ka=*(const __attribute__((address_space(3))) f32x4_t*)(tab3+(j*64+16*d0+8*hi)*4); const f32x4_t kb2=*(const __attribute__((address_space(3))) f32x4_t*)(tab3+(j*64+16*d0+8*hi+4)*4);
        #pragma unroll
        for(int i=0;i<4;++i){ s+=__uint_as_float(((unsigned)(unsigned short)qr[d0][i])<<16)*ka[i]; s+=__uint_as_float(((unsigned)(unsigned short)qr[d0][4+i])<<16)*kb2[i]; } }
      auto rr=__builtin_amdgcn_permlane32_swap(__float_as_uint(s),__float_as_uint(s),false,false); s=__uint_as_float(rr[0])+__uint_as_float(rr[1]);
      gt[j]=(j<qb)?s:-INFINITY; }
    #pragma unroll
    for(int j=0;j<7;++j){ int rk=0;
      #pragma unroll
      for(int k=0;k<7;++k){ if(k!=j){ rk+=(gt[k]>gt[j]||(gt[k]==gt[j]&&k<j))?1:0; } }
      if(j<qb&&rk<3)selmask|=(1u<<j); } }
  CINIT(pA0,pA1,0); qkt(pA0,pA1,Kbase,qr,r32,hi);asm volatile("s_nop 15\n\ts_nop 7":"+v"(pA0),"+v"(pA1));CMASK(pA0,pA1,0);
  START(pA0,pA1);
  _Pragma("unroll") for(int r=0;r<16;++r)pA1[r]=__builtin_amdgcn_exp2f(pA1[r]);
  WAIT_BAR(0);
  DMA_K(3,0);DMA_V(1,SLOTB);
  ROT();
  kload8(kf,kp0+sl_cur);
  WAIT_BAR(2);
  s16x4 vlo[8],vhi[8]; u32x4 pw0,pw1,pw2,pw3;
  #define PKW(P,B) cvtpk_s(P[B],P[B+1])
  #define PAF(k) __builtin_bit_cast(bf16x8,pw##k)
  #define VFR(i) (bf16x8){vlo[i][0],vlo[i][1],vlo[i][2],vlo[i][3],vhi[i][0],vhi[i][1],vhi[i][2],vhi[i][3]}
  #define PIN(x) asm volatile("":"+v"(x))
  #define MX3(a,b,c) __builtin_fmaxf(__builtin_fmaxf((a),(b)),(c))
  #define GAPA(MF,A0,A1,A2,A3,W0,W1,PW) do{ MF; sacc+=A0; sacc+=A1; sacc+=A2; sacc+=A3; PIN(sacc); W0; W1; PIN(PW); SBAR(); }while(0)
  #define EX(v) __builtin_amdgcn_exp2f(v)
  #define GAPB(MF,X,B) do{ MF; X[B]=EX(X[B]); X[B+1]=EX(X[B+1]); X[B+2]=EX(X[B+2]); X[B+3]=EX(X[B+3]); PIN(X); SBAR(); }while(0)
  #define VRD(i) do{ vlo[i]=vtr(vp_+(((i)>>2)*4096+((i)&3)*1024)); vhi[i]=vtr(vp_+(((i)>>2)*4096+((i)&3)*1024+512)); }while(0)
  #define KRD(G,j) do{ if(G){ kload2(kf,kp0+sl_next,j); SBAR(); } }while(0)
  #define STEP(C0,C1,P0,P1,t,GK,GV,GL) do{ SBAR(); CINIT(C0,C1,t); SBAR(); \
    const lds_cptr vp_=vp0+sl_prev; \
    VRD(0); SBAR(); float sacc=(P0[0]+P0[1]); \
    GAPA(C0=__builtin_amdgcn_mfma_f32_32x32x16_bf16(kf[0],qr[0],C0,0,0,0), P0[2],P0[3],P0[4],P0[5],     pw0[0]=PKW(P0,0), pw0[1]=PKW(P0,2), pw0); \
    VRD(4); SBAR(); GAPA(C1=__builtin_amdgcn_mfma_f32_32x32x16_bf16(kf[1],qr[0],C1,0,0,0), P0[6],P0[7],P0[8],P0[9],     pw0[2]=PKW(P0,4), pw0[3]=PKW(P0,6), pw0); \
    VRD(1); SBAR(); GAPA(C0=__builtin_amdgcn_mfma_f32_32x32x16_bf16(kf[2],qr[1],C0,0,0,0),   P0[10],P0[11],P0[12],P0[13], pw1[0]=PKW(P0,8), pw1[1]=PKW(P0,10), pw1); \
    VRD(5); SBAR(); GAPA(C1=__builtin_amdgcn_mfma_f32_32x32x16_bf16(kf[3],qr[1],C1,0,0,0),   P0[14],P0[15],P1[0],P1[1],   pw1[2]=PKW(P0,12),pw1[3]=PKW(P0,14), pw1); \
    VRD(2); SBAR(); GAPA(C0=__builtin_amdgcn_mfma_f32_32x32x16_bf16(kf[4],qr[2],C0,0,0,0),   P1[2],P1[3],P1[4],P1[5],     pw2[0]=PKW(P1,0), pw2[1]=PKW(P1,2), pw2); \
    VRD(6); SBAR(); GAPA(C1=__builtin_amdgcn_mfma_f32_32x32x16_bf16(kf[5],qr[2],C1,0,0,0),   P1[6],P1[7],P1[8],P1[9],     pw2[2]=PKW(P1,4), pw2[3]=PKW(P1,6), pw2); \
    VRD(3); SBAR(); GAPA(C0=__builtin_amdgcn_mfma_f32_32x32x16_bf16(kf[6],qr[3],C0,0,0,0),   P1[10],P1[11],P1[12],P1[13], pw3[0]=PKW(P1,8), pw3[1]=PKW(P1,10), pw3); \
    VRD(7); SBAR(); GAPA(C1=__builtin_amdgcn_mfma_f32_32x32x16_bf16(kf[7],qr[3],C1,0,0,0),   P1[14],P1[15],0.f,0.f,       pw3[2]=PKW(P1,12),pw3[3]=PKW(P1,14), pw3); \
    l_reg+=sacc; \
    if(GK){DMA_K((t)+3,sl_cur);} if(GV){DMA_V((t)+1,sl_next);} \
    CMASK(C0,C1,t); \
    { float a=MX3(C0[0],C0[1],C1[0]),b=MX3(C0[2],C0[3],C1[1]); a=MX3(a,C1[2],C1[3]); \
      _Pragma("unroll") for(int r=4;r<16;r+=4){a=MX3(a,C0[r],C0[r+1]);b=MX3(b,C0[r+2],C0[r+3]);a=MX3(a,C1[r],C1[r+1]);b=MX3(b,C1[r+2],C1[r+3]);} \
      float rm=__builtin_fmaxf(a,b); { auto rr=__builtin_amdgcn_permlane32_swap(__float_as_uint(rm),__float_as_uint(rm),false,false); rm=__builtin_fmaxf(__uint_as_float(rr[0]),__uint_as_float(rr[1])); } \
      resc=false; \
      if(__builtin_expect(__any(rm>(float)THRL),0)){ const float dl=__builtin_fmaxf(rm,0.f); mhat+=dl; \
        _Pragma("unroll") for(int r=0;r<16;++r){C0[r]-=dl;C1[r]-=dl;} \
        const float f=__builtin_amdgcn_exp2f(-dl); l_reg*=f; if(hi==0)wsf[r32]=f; resc=true; } } \
    SBAR(); \
    GAPB(o[0]=__builtin_amdgcn_mfma_f32_32x32x16_bf16(PAF(0),VFR(0),o[0],0,0,0), C0,0); \
    GAPB(o[1]=__builtin_amdgcn_mfma_f32_32x32x16_bf16(PAF(0),VFR(4),o[1],0,0,0), C0,4); \
    KRD(GL,0); GAPB(o[0]=__builtin_amdgcn_mfma_f32_32x32x16_bf16(PAF(1),VFR(1),o[0],0,0,0), C0,8); \
    KRD(GL,1); GAPB(o[1]=__builtin_amdgcn_mfma_f32_32x32x16_bf16(PAF(1),VFR(5),o[1],0,0,0), C0,12); \
    KRD(GL,2); GAPB(o[0]=__builtin_amdgcn_mfma_f32_32x32x16_bf16(PAF(2),VFR(2),o[0],0,0,0), C1,0); \
    KRD(GL,3); GAPB(o[1]=__builtin_amdgcn_mfma_f32_32x32x16_bf16(PAF(2),VFR(6),o[1],0,0,0), C1,4); \
    GAPB(o[0]=__builtin_amdgcn_mfma_f32_32x32x16_bf16(PAF(3),VFR(3),o[0],0,0,0), C1,8); \
    GAPB(o[1]=__builtin_amdgcn_mfma_f32_32x32x16_bf16(PAF(3),VFR(7),o[1],0,0,0), C1,12); \
    }while(0)
  int t=1;
  for(;t+5<NT;t+=2){
    STEP(pB0,pB1,pA0,pA1,t,true,true,true);     WAIT_BAR(2); RESC(); ROT();
    STEP(pA0,pA1,pB0,pB1,t+1,true,true,true);   WAIT_BAR(2); RESC(); ROT();
  }
  #define ENDW(tt) do{ if((tt)+3<NT){WAIT_BAR(2);} else if((tt)+2<NT){WAIT_BAR(1);} else {WAIT_BAR(0);} }while(0)
  for(;t+1<NT;t+=2){
    STEP(pB0,pB1,pA0,pA1,t,(t+3<NT),(t+1<NT),(t+1<NT));       ENDW(t);   RESC(); ROT();
    STEP(pA0,pA1,pB0,pB1,t+1,(t+4<NT),(t+2<NT),(t+2<NT));     ENDW(t+1); RESC(); ROT();
  }
  STEP(pB0,pB1,pA0,pA1,NT-1,false,false,false); RESC();
  { float sacc=pB0[0]+pB0[1]; _Pragma("unroll") for(int r=2;r<16;++r)sacc+=pB0[r]; _Pragma("unroll") for(int r=0;r<16;++r)sacc+=pB1[r]; l_reg+=sacc;
    pw0=(u32x4){PKW(pB0,0),PKW(pB0,2),PKW(pB0,4),PKW(pB0,6)};pw1=(u32x4){PKW(pB0,8),PKW(pB0,10),PKW(pB0,12),PKW(pB0,14)};pw2=(u32x4){PKW(pB1,0),PKW(pB1,2),PKW(pB1,4),PKW(pB1,6)};pw3=(u32x4){PKW(pB1,8),PKW(pB1,10),PKW(pB1,12),PKW(pB1,14)};
    SBAR(); pv(o,vb0+sl_cur,PAF(0),PAF(1),PAF(2),PAF(3)); }
  #undef PKW
  #undef PAF
  #undef VFR
  #undef PIN
  #undef MX3
  #undef GAPA
  #undef GAPB
  #undef EX
  #undef VRD
  #undef KRD
  #undef STEP
  #undef ENDW
  {auto rr=__builtin_amdgcn_permlane32_swap(__float_as_uint(l_reg),__float_as_uint(l_reg),false,false);l_reg=__uint_as_float(rr[0])+__uint_as_float(rr[1]);}
  if(hi==0)wsf[32+r32]=l_reg;asm volatile("s_waitcnt lgkmcnt(0)":::"memory");
  float rli[16];
  #pragma unroll
  for(int r=0;r<16;++r)rli[r]=__builtin_amdgcn_rcpf(wsf[32+crow(r,hi)]);
  bf16*Ow=O+(rowbase+q0+wid*QBLK)*DM+h*D;
  { bf16*stg=(bf16*)(shm+LDS_OST)+wid*2048;
    #pragma unroll
    for(int r=0;r<16;++r){const int orow=crow(r,hi);
      #pragma unroll
      for(int d0=0;d0<2;++d0)stg[orow*64+d0*32+r32]=__float2bfloat16(o[d0][r]*rli[r]);}
    asm volatile("s_waitcnt lgkmcnt(0)":::"memory");
    int lv_=lane; asm volatile("":"+v"(lv_));
    #pragma unroll
    for(int i=0;i<4;++i){const int row=i*8+(lv_>>3),ch=lv_&7; const u32x4 v=*(const u32x4*)(stg+row*64+ch*8); ATTN_STORE16(Ow+(long)row*DM+ch*8,v);} }
  asm volatile("s_waitcnt lgkmcnt(0)\n\ts_barrier":::"memory");
  #undef DMA_K
  #undef DMA_V
  #undef CMASK
  #undef TMASK
  #undef CINIT
  #undef START
  #undef RESC
  #undef ROT
}
constexpr int ATTN_LDS_BYTES=LDS_BYTES;
struct AttnTensors { const bf16* Q; const bf16* K; const bf16* V; bf16* O; };
struct AttnUnit { int b, h, qb; };
struct StaticOrder {
  int vcu, G;
  __device__ __forceinline__ explicit StaticOrder(int grid,int vcu_):vcu(vcu_),G(grid){}
  __device__ __forceinline__ bool next(int i,AttnUnit&u)const{ const int L=i*G+vcu; if(L>=2048)return false; const int v=L&255,k=L>>8,s=v>>1; const int moba=(k>>2)&1; const int setA=((v&1)^moba);
    const int kk=k&3; const int qa=(kk==0)?0:(kk==1)?3:(kk==2)?4:7, qb2=(kk==0)?1:(kk==1)?2:(kk==2)?5:6;
    u.b=s>>3; u.h=(s&7)+8*moba; u.qb=setA?qb2:qa; return true; }
};
template<class Sched,int THRL=8> __device__ __forceinline__ void attn_phase(int tid,char*lds,const AttnTensors&T,const Sched&S,const float*kbias,const float*kpart,const float*relb){
  AttnUnit u;
  for(int i=0;S.next(i,u);++i){ AttnExtra X; X.kbias=kbias+(long)(u.b*8+(u.h&7))*SEQ; X.kpart=kpart; X.relb=relb;
#if !defined(ATT_ONLY) || ATT_ONLY==0
    if(u.h<8) attn_unit<THRL,0>(u.b,u.h,u.qb,T.Q,T.K,T.V,T.O,lds,X,tid);
#endif
#if !defined(ATT_ONLY) || ATT_ONLY==1
    if(u.h>=8) attn_unit<THRL,1>(u.b,u.h,u.qb,T.Q,T.K,T.V,T.O,lds,X,tid);
#endif
  }
}
#undef SBAR
#undef WAIT_BAR
}
#define XB_TMO      128
#define XB_XCNT(j)  (256  + 64 * (j))
#define XB_XSUB(j)  (1280 + 64 * (j))
#define XB_XGEN(j)  (2304 + 64 * (j))
#define XB_TOP      3328
#define XB_TOPGEN   3392
#define XCD_BAR_WORDS 3456
#define XB_SPIN_CAP (1u << 18)

__device__ __forceinline__ unsigned xb_ld(unsigned* p)              { return __hip_atomic_load(p, __ATOMIC_RELAXED, __HIP_MEMORY_SCOPE_AGENT); }
__device__ __forceinline__ unsigned xb_add(unsigned* p, unsigned v) { return __hip_atomic_fetch_add(p, v, __ATOMIC_RELAXED, __HIP_MEMORY_SCOPE_AGENT); }
__device__ __forceinline__ unsigned xb_xcc_id() { return (unsigned)__builtin_amdgcn_s_getreg((3 << 11) | 20) & 0xFu; }
#define XB_SPIN(cond, bar) do { unsigned _sp = 0; while (cond) { __builtin_amdgcn_s_sleep(1); \
    if ((++_sp & 255u) == 0u) { if (xb_ld(&(bar)[XB_TMO])) break; if (_sp > XB_SPIN_CAP) { atomicAdd(&(bar)[XB_TMO], 1u); break; } } } } while (0)

struct XcdBarrier {
    unsigned* bar; unsigned x;
    volatile LAS unsigned* st;
};

__device__ __forceinline__ XcdBarrier xcd_barrier_post(unsigned* bar, volatile LAS unsigned* st) {
    XcdBarrier b; b.bar = bar; b.x = xb_xcc_id(); b.st = st;
    if (threadIdx.x == 0) (void)xb_add(&bar[XB_XCNT(b.x)], 1u);
    return b;
}
__device__ __forceinline__ void xcd_barrier_complete(unsigned* bar, unsigned x, unsigned& nloc, unsigned& nx) {
    const unsigned G = gridDim.x * gridDim.y * gridDim.z;
    unsigned sum, cnt, mine, sp = 0u;
    for (;;) {
        sum = 0u; cnt = 0u; mine = 0u;
#pragma unroll
        for (unsigned j = 0; j < 16; ++j) { const unsigned c = xb_ld(&bar[XB_XCNT(j)]); sum += c; cnt += (c > 0u) ? 1u : 0u; mine = (j == x) ? c : mine; }
        if (sum == G) break;
        __builtin_amdgcn_s_sleep(1);
        if ((++sp & 255u) == 0u) { if (xb_ld(&bar[XB_TMO])) break; if (sp > XB_SPIN_CAP) { atomicAdd(&bar[XB_TMO], 1u); break; } }
    }
    nloc = mine > 0u ? mine : 1u; nx = cnt > 0u ? cnt : 1u;
}

__device__ __forceinline__ void xcd_barrier(const XcdBarrier& b) {
    asm volatile("s_waitcnt vmcnt(0)" ::: "memory");
    __syncthreads();
    if (threadIdx.x == 0) {
        unsigned* bar = b.bar;
        __builtin_amdgcn_s_waitcnt(0);
        unsigned nloc = b.st[0], nx = b.st[1];
        if (nloc == 0u) { xcd_barrier_complete(bar, b.x, nloc, nx); b.st[0] = nloc; b.st[1] = nx; }
        const unsigned old = xb_add(&bar[XB_XSUB(b.x)], 1u);
        const unsigned gen = old / nloc;
        if (old + 1u == (gen + 1u) * nloc) {
            __builtin_amdgcn_fence(__ATOMIC_RELEASE, "agent");
            asm volatile("s_waitcnt vmcnt(0)" ::: "memory");
            const unsigned og = xb_add(&bar[XB_TOP], 1u);
            const unsigned tg = og / nx;
            if (og + 1u == (tg + 1u) * nx) xb_add(&bar[XB_TOPGEN], 1u);
            else XB_SPIN(xb_ld(&bar[XB_TOPGEN]) == tg, bar);
            __builtin_amdgcn_fence(__ATOMIC_ACQUIRE, "agent");
            xb_add(&bar[XB_XGEN(b.x)], 1u);
            asm volatile("s_waitcnt vmcnt(0)" ::: "memory");
        } else {
            XB_SPIN(xb_ld(&bar[XB_XGEN(b.x)]) == gen, bar);
            __builtin_amdgcn_fence(__ATOMIC_ACQUIRE, "agent");
            asm volatile("s_waitcnt vmcnt(0)" ::: "memory");
        }
    }
    __syncthreads();
}
constexpr int NWAVES = 8;
#define LDS_WAIT() asm volatile("s_waitcnt lgkmcnt(0)" ::: "memory")
#define VM_WAIT() asm volatile("s_waitcnt vmcnt(0)" ::: "memory")
__device__ __forceinline__ float wave_sum(float v) {
#pragma unroll
    for (int o = 1; o < 64; o <<= 1) v += __shfl_xor(v, o);
    return v;
}
__device__ __forceinline__ void row_load(const float* p, int lane, f32x4 (&v)[4]) {
    const GAS f32x4* xr = (const GAS f32x4*)p + lane;
#pragma unroll
    for (int j = 0; j < 4; ++j) v[j] = xr[64 * j];
}
__device__ __forceinline__ void row_store_f32(float* p, int lane, const f32x4 (&v)[4]) {
    GAS f32x4* o = (GAS f32x4*)p + lane;
#pragma unroll
    for (int j = 0; j < 4; ++j) o[64 * j] = v[j];
}
__device__ __forceinline__ void row_store_bf16(bf16_t* p, int lane, const f32x4 (&v)[4]) {
    GAS u32x2* o = (GAS u32x2*)p + lane;
#pragma unroll
    for (int j = 0; j < 4; ++j) { u32x2 w; w.x = cvt_pk_bf16(v[j][0], v[j][1]); w.y = cvt_pk_bf16(v[j][2], v[j][3]); o[64 * j] = w; }
}
__device__ __forceinline__ void row_layernorm(f32x4 (&v)[4], const f32x4 (&g)[4], const f32x4 (&b)[4]) {
    float s = 0.f;
#pragma unroll
    for (int j = 0; j < 4; ++j) s += (v[j][0] + v[j][1]) + (v[j][2] + v[j][3]);
    const float mean = wave_sum(s) * (1.f / DM); float s2 = 0.f;
#pragma unroll
    for (int j = 0; j < 4; ++j) { v[j] = v[j] - mean; s2 += (v[j][0] * v[j][0] + v[j][1] * v[j][1]) + (v[j][2] * v[j][2] + v[j][3] * v[j][3]); }
    const float rstd = 1.f / sqrtf(wave_sum(s2) * (1.f / DM) + LN_EPS);
#pragma unroll
    for (int j = 0; j < 4; ++j) v[j] = v[j] * rstd * g[j] + b[j];
}
template <int H, int MASK, int N> __device__ __forceinline__ void bfly_step(float (&v)[N], int lane) {
    const bool up = (lane & MASK) != 0;
#pragma unroll
    for (int i = 0; i < H; ++i) { const float a = v[i], b = v[i + H]; const float send = up ? a : b, keep = up ? b : a; v[i] = keep + __shfl_xor(send, MASK); }
}
__device__ __forceinline__ void butterfly64(float (&v)[64], int lane) { bfly_step<32, 32>(v, lane); bfly_step<16, 16>(v, lane); bfly_step<8, 8>(v, lane); bfly_step<4, 4>(v, lane); bfly_step<2, 2>(v, lane); bfly_step<1, 1>(v, lane); }
__device__ __forceinline__ void butterfly32(float (&v)[32], int lane) { bfly_step<16, 32>(v, lane); bfly_step<8, 16>(v, lane); bfly_step<4, 8>(v, lane); bfly_step<2, 4>(v, lane); bfly_step<1, 2>(v, lane); v[0] += __shfl_xor(v[0], 1); }
template <int E> __device__ __forceinline__ void thin_dot(const f32x4 (&xn)[4][4], const LAS float* w, int ws, int lane, float (&acc)[4 * E]) {
#pragma unroll
    for (int i = 0; i < 4 * E; ++i) acc[i] = 0.f;
#pragma unroll
    for (int e = 0; e < E; ++e)
#pragma unroll
        for (int j = 0; j < 4; ++j) { const f32x4 wv = *(const LAS f32x4*)(w + e * ws + 4 * lane + 256 * j);
#pragma unroll
            for (int r = 0; r < 4; ++r) { float a = acc[r * E + e]; a = fmaf(xn[r][j][0], wv[0], a); a = fmaf(xn[r][j][1], wv[1], a); a = fmaf(xn[r][j][2], wv[2], a); a = fmaf(xn[r][j][3], wv[3], a); acc[r * E + e] = a; } }
}
__device__ __forceinline__ float log_sigmoid(float z) { const float a = fabsf(z); return fminf(z, 0.f) - log1pf(__expf(-a)); }

__device__ __forceinline__ void forget_rows(const f32x4 (&xn)[4][4], const LAS float* wf, const float* bf, float* logf, int t0, int lane) {
    float acc[32]; thin_dot<8>(xn, wf, 1024, lane, acc); butterfly32(acc, lane);
    const int r = lane >> 4, h = (lane >> 1) & 7, t = t0 + r;
    if ((lane & 1) == 0) logf[(size_t)((t >> 11) * 8 + h) * SEQ + (t & (SEQ - 1))] = log_sigmoid(acc[0] + bf[h]);
}
__device__ __forceinline__ void load_wf(const float* w_in_l, LAS float* wf, int tid) {
    for (int idx = tid; idx < 8192; idx += NWAVES * 64) { const int k = idx >> 3, h = idx & 7; wf[h * 1024 + k] = w_in_l[(size_t)k * IN_COLS + FCOL + h]; }
}

template <int MAPK> __device__ __forceinline__ int wt_map(int n) {
    if (MAPK == 0) return n;
    if (MAPK == 1) return n < FCOL ? n : (n < FCOL + 8 ? -1 : n - 8);
    return ((n & 1023) >> 7) * 256 + (n >> 10) * 128 + (n & 127);
}
template <int MAPK> __device__ __forceinline__ void transpose_item(const float* W, int K, int N, bf16_t* WT, LAS float* scr, int item, int lane) {
    const int nblk = (N + 31) / 32, kb = item / nblk, nb = item % nblk, k0 = 64 * kb, n0 = 32 * nb;
    const int nn = n0 + (lane & 31);
#pragma unroll 8
    for (int i = 0; i < 32; ++i) { const int kk = 2 * i + (lane >> 5); scr[kk * 33 + (lane & 31)] = (nn < N) ? W[(size_t)(k0 + kk) * N + nn] : 0.f; }
    LDS_WAIT(); asm volatile("" ::: "memory");
    const int c = lane & 7;
#pragma unroll
    for (int j = 0; j < 4; ++j) { const int nl = (lane >> 3) + 8 * j, n = n0 + nl; const int dr = wt_map<MAPK>(n); const LAS float* s = scr + (8 * c) * 33 + nl;
        u32x4 o; o.x = cvt_pk_bf16(s[0 * 33], s[1 * 33]); o.y = cvt_pk_bf16(s[2 * 33], s[3 * 33]); o.z = cvt_pk_bf16(s[4 * 33], s[5 * 33]); o.w = cvt_pk_bf16(s[6 * 33], s[7 * 33]);
        if (n < N && dr >= 0) *(GAS u32x4*)(WT + (size_t)dr * K + k0 + 8 * c) = o; }
    LDS_WAIT(); asm volatile("" ::: "memory");
}
constexpr size_t MiB = 1u << 20;
constexpr size_t WS_CTL = 0, CTL_ZERO_BYTES = 1 * MiB;
constexpr size_t WS_WIN = 2 * MiB, WS_WO = 26 * MiB, WS_WCQ = 34 * MiB, WS_WCK = 42 * MiB, WS_WCV = 50 * MiB, WS_WCO = 58 * MiB;
constexpr size_t WS_WGU = 66 * MiB, WS_WD = 578 * MiB;
constexpr size_t WS_XB = 834 * MiB, WS_Q = 898 * MiB, WS_K = 962 * MiB, WS_V = 1026 * MiB;
constexpr size_t WS_MEMB = 1090 * MiB, WS_KC = 1098 * MiB, WS_VT = 1130 * MiB;
constexpr size_t WS_LOGF = 1162 * MiB, WS_KB = 1163 * MiB, WS_KPART = 1164 * MiB;
constexpr size_t WS_ASGE = 1165 * MiB, WS_ASGR = WS_ASGE + 512 * 1024, WS_ASGG = 1166 * MiB;
constexpr size_t WS_STOK = 1167 * MiB;
constexpr size_t WS_ACT = 1171 * MiB, WS_YEXP = 1443 * MiB, WS_END = 1715 * MiB;
static_assert(WS_ACT + (size_t)MAXTILES * 256 * DM * 2 <= WS_YEXP && WS_YEXP + (size_t)MAXTILES * 256 * DM * 2 <= WS_END, "d_ws map");
constexpr int CW_TMO = 0, CW_CODE = 1;
constexpr int CW_BAR = 4096;
constexpr int CW_CNT = 16384;
static_assert((CW_CNT + NL * NE * 64) * 4 <= (int)CTL_ZERO_BYTES && CW_BAR + XCD_BAR_WORDS <= CW_CNT, "CTL words inside the memset region");
constexpr int RING_OFF = 0, RING_BYTES = 131072;
constexpr int XCH_OFF = RING_BYTES;
constexpr int MOE_OFF = XCH_OFF + 8192;
constexpr int ARGT_OFF = MOE_OFF + 288;
constexpr int MISC_OFF = MOE_OFF + 512;
constexpr int LDS_BYTES = 147456;
static_assert(MISC_OFF + 128 <= LDS_BYTES, "LDS map");
constexpr int NPHASE = 2 + 12 * NL;

struct Args { const float* in[22]; float* out; unsigned char* ws; int ph_lo, ph_hi; };

struct KVOrder {
    int G, c;
    __device__ __forceinline__ bool next(int i, pg8::Unit& u) const {
        const long L = (long)i * G + c; if (L >= 512) return false;
        const int wgid = pg8::xcd_chunk((int)L, 512), l = wgid >> 7, r = wgid & 127, kind = r >> 6, rr = r & 63;
        const int pm = kind ? (rr & 3) : (rr & 15), pn = kind ? (rr >> 2) : (rr >> 4);
        u.abyte = (long)(kind ? WS_WCV + (size_t)l * 2 * MiB : WS_MEMB) + (long)pm * 256 * DM * 2;
        u.bbyte = (long)(kind ? WS_MEMB : WS_WCK + (size_t)l * 2 * MiB) + (long)pn * 256 * DM * 2;
        u.orow = pm * 256; u.ocol = pn * 256; u.aux = l * 2 + kind; u.grow = 0; u.gcnt = 256; return true;
    }
};
struct EpiKV {
    static constexpr bool PERM = true;
    bf16_t* KC; bf16_t* VT;
    __device__ __forceinline__ void operator()(const f32x4 (&acc)[2][2][4][2], const pg8::Unit& u, const pg8::EpiCtx& c) const {
        const int l = u.aux >> 1, kind = u.aux & 1, ldc = kind ? TM : DM;
        bf16_t* O = (kind ? VT : KC) + (size_t)l * TM * DM;
        const int row0 = u.orow + c.wr * 64 + c.fr, col0 = u.ocol + c.wc * 32 + 8 * c.fq;
#pragma unroll
        for (int ai = 0; ai < 2; ++ai)
#pragma unroll
            for (int m = 0; m < 4; ++m) { bf16_t* rowp = O + (size_t)(row0 + ai * 128 + m * 16) * ldc + col0;
#pragma unroll
                for (int bj = 0; bj < 2; ++bj) { const f32x4 v0 = acc[ai][bj][m][0], v1 = acc[ai][bj][m][1];
                    u32x4 w; w.x = cvt_pk_bf16(v0[0], v0[1]); w.y = cvt_pk_bf16(v0[2], v0[3]); w.z = cvt_pk_bf16(v1[0], v1[1]); w.w = cvt_pk_bf16(v1[2], v1[3]);
                    *(u32x4*)(rowp + bj * 128) = w; } }
    }
};

#define PHASE_TID() int lane_; asm volatile("v_mbcnt_lo_u32_b32 %0, -1, 0\n\tv_mbcnt_hi_u32_b32 %0, -1, %0" : "=v"(lane_)); const int lane = lane_; const int wave = wave0; const int ptid = wave * 64 + lane; (void)lane; (void)wave; (void)ptid
__device__ __forceinline__ const float* argp(const LAS unsigned long long* tab, int i) {
    const unsigned long long v = tab[i]; const unsigned lo = __builtin_amdgcn_readfirstlane((unsigned)v), hi = __builtin_amdgcn_readfirstlane((unsigned)(v >> 32));
    return (const float*)(((unsigned long long)hi << 32) | lo);
}
__global__ void __launch_bounds__(NWAVES * 64, 2) skel_fwd(Args args) {
    extern __shared__ __attribute__((aligned(16))) unsigned char lds_raw[];
    LAS unsigned char* lds = (LAS unsigned char*)lds_raw;
    volatile LAS unsigned* MISC = (volatile LAS unsigned*)(lds + MISC_OFF);
    const int G = gridDim.x; const int bx = blockIdx.x; const int vcu = (G % 8 == 0) ? (bx % 8) * (G / 8) + bx / 8 : bx;
    const int lo = args.ph_lo, hi = args.ph_hi;
    const int wave0 = __builtin_amdgcn_readfirstlane((int)threadIdx.x >> 6);
    LAS unsigned long long* ARGT = (LAS unsigned long long*)(lds + ARGT_OFF);
    { const int tid0 = threadIdx.x;
      for (int u = tid0; u < (LDS_BYTES - XCH_OFF) / 4; u += NWAVES * 64) ((LAS unsigned*)(lds + XCH_OFF))[u] = 0u;
      __syncthreads();
      if (tid0 == 0) {
#pragma unroll
          for (int i = 0; i < 22; ++i) ARGT[i] = (unsigned long long)args.in[i];
          ARGT[22] = (unsigned long long)args.out; ARGT[23] = (unsigned long long)args.ws; }
      __syncthreads(); }
    if (hi - lo > 1) { const XcdBarrier b0 = xcd_barrier_post((unsigned*)(args.ws + WS_CTL) + CW_BAR, MISC + 8); if (threadIdx.x == 0) MISC[10] = b0.x; }
    __syncthreads();
#ifndef PHASE_MASK
#define PHASE_MASK 0xFFFF
#endif
#define PH_ON(kind) (((PHASE_MASK) >> (kind)) & 1)
#define IN(k) (lo <= (k) && (k) < hi)
#define BOTH(k) (IN(k) && IN((k) + 1))
#define SEAM(k) do { if (BOTH(k)) { XcdBarrier b_; b_.bar = (unsigned*)WSP() + CW_BAR; b_.x = (unsigned)__builtin_amdgcn_readfirstlane((int)MISC[10]); b_.st = MISC + 8; xcd_barrier(b_); } } while (0)
#define ARGF(i) argp(ARGT, (i))
#define WSP() ((unsigned char*)ARGF(23))
    LAS int* TP = (LAS int*)(lds + MOE_OFF); LAS int* CNT = TP + 40;
    LAS unsigned char* xch = lds + XCH_OFF;
    const int NGW = G * NWAVES;

    if (PH_ON(0) && IN(0)) {
        PHASE_TID(); unsigned char* ws = WSP(); const int gw = vcu * NWAVES + wave;
        const float* x_in = ARGF(0); const float* mem = ARGF(1); const float* w_in = ARGF(2); const float* b_forget = ARGF(3); const float* w_mix_out = ARGF(4);
        const float* w_cq = ARGF(8); const float* w_ck = ARGF(9); const float* w_cv = ARGF(10); const float* w_co = ARGF(11); const float* w_gate_up = ARGF(16); const float* w_down = ARGF(18);
        LAS float* scr = (LAS float*)(lds + RING_OFF + wave * 16384);
        constexpr int I_IN = 16 * 97, I_SQ = 16 * 32, I_GU = 16 * 64, PER_L = I_IN + 5 * I_SQ + NE * I_GU + NE * I_SQ;
        for (int it = gw; it < NL * PER_L; it += NGW) {
            const int l = it / PER_L; int r = it % PER_L;
            if (r < I_IN) { transpose_item<1>(w_in + (size_t)l * DM * IN_COLS, DM, IN_COLS, (bf16_t*)(ws + WS_WIN) + (size_t)l * IN_N * DM, scr, r, lane); continue; } r -= I_IN;
            if (r < 5 * I_SQ) { const int which = r / I_SQ, item = r % I_SQ;
                const float* W = (which == 0 ? w_mix_out : which == 1 ? w_cq : which == 2 ? w_ck : which == 3 ? w_cv : w_co) + (size_t)l * DM * DM;
                bf16_t* WT = (bf16_t*)(ws + (which == 0 ? WS_WO : which == 1 ? WS_WCQ : which == 2 ? WS_WCK : which == 3 ? WS_WCV : WS_WCO)) + (size_t)l * DM * DM;
                transpose_item<0>(W, DM, DM, WT, scr, item, lane); continue; } r -= 5 * I_SQ;
            if (r < NE * I_GU) { const int e = r / I_GU, item = r % I_GU;
                transpose_item<2>(w_gate_up + (size_t)(l * NE + e) * DM * 2048, DM, 2048, (bf16_t*)(ws + WS_WGU) + (size_t)(l * NE + e) * 2048 * DM, scr, item, lane); continue; } r -= NE * I_GU;
            { const int e = r / I_SQ, item = r % I_SQ;
                transpose_item<0>(w_down + (size_t)(l * NE + e) * DM * DM, DM, DM, (bf16_t*)(ws + WS_WD) + (size_t)(l * NE + e) * DM * DM, scr, item, lane); }
        }
        __syncthreads();
        LAS float* wf = (LAS float*)(lds + RING_OFF);
        load_wf(w_in, wf, ptid);
        __syncthreads();
        bf16_t* XB = (bf16_t*)(ws + WS_XB); float* LOGF = (float*)(ws + WS_LOGF); bf16_t* MEMB = (bf16_t*)(ws + WS_MEMB);
        for (int rg = gw; rg < T / 16; rg += NGW)
            for (int g4 = 0; g4 < 4; ++g4) { const int t0 = rg * 16 + g4 * 4; f32x4 xn[4][4];
#pragma unroll
                for (int r = 0; r < 4; ++r) { row_load(x_in + (size_t)(t0 + r) * DM, lane, xn[r]); row_store_bf16(XB + (size_t)(t0 + r) * DM, lane, xn[r]); }
                forget_rows(xn, wf, b_forget, LOGF, t0, lane); }
        for (int m = gw; m < TM; m += NGW) { f32x4 v[4]; row_load(mem + (size_t)m * DM, lane, v); row_store_bf16(MEMB + (size_t)m * DM, lane, v); }
        __syncthreads();
        SEAM(0);
    }
    if (PH_ON(1) && IN(1)) {
        PHASE_TID(); unsigned char* ws = WSP();
        pg8::Gemm g{(const bf16_t*)ws, (const bf16_t*)ws, DM, DM, DM, nullptr}; KVOrder S{G, bx}; EpiKV E{(bf16_t*)(ws + WS_KC), (bf16_t*)(ws + WS_VT)};
        pg8::gemm_phase<EpiKV, KVOrder, false, true>(ptid, lds + RING_OFF, xch, g, S, E);
        SEAM(1);
    }
    for (int l = 0; l < NL; ++l) {
        const int pb = 2 + 12 * l;
        if (PH_ON(2) && IN(pb + 0)) {
            PHASE_TID(); unsigned char* ws = WSP();
            { float* LOGF = (float*)(ws + WS_LOGF); float* KBIAS = (float*)(ws + WS_KB);
              for (int sq = bx; sq < NB * 8; sq += G) {
                const f32x4 v = *(const f32x4*)(LOGF + (size_t)sq * SEQ + ptid * 4);
                const float p0 = v[0], p1 = p0 + v[1], p2 = p1 + v[2], p3 = p2 + v[3];
                float inc = p3;
#pragma unroll
                for (int o = 1; o < 64; o <<= 1) { const float n = __shfl_up(inc, o); if (lane >= o) inc += n; }
                LAS float* wt = (LAS float*)xch;
                if (lane == 63) wt[wave] = inc;
                __syncthreads();
                float off = inc - p3;
                for (int w = 0; w < wave; ++w) off += wt[w];
                f32x4 o; o[0] = -(off + p0) * LOG2E; o[1] = -(off + p1) * LOG2E; o[2] = -(off + p2) * LOG2E; o[3] = -(off + p3) * LOG2E;
                *(f32x4*)(KBIAS + (size_t)sq * SEQ + ptid * 4) = o;
                __syncthreads();
              } }
            pg8::Gemm g{(const bf16_t*)(ws + WS_XB), (const bf16_t*)(ws + WS_WIN) + (size_t)l * IN_N * DM, DM, DM, DM, nullptr};
            pg8::GridOrder<0> S; S.init(T / 256, IN_N / 256, G, bx, DM, DM);
            pg8::EpiQKV E{(bf16_t*)(ws + WS_Q), (bf16_t*)(ws + WS_K), (bf16_t*)(ws + WS_V), (float*)(ws + WS_KPART)};
            pg8::gemm_phase<pg8::EpiQKV, pg8::GridOrder<0>, false, true>(ptid, lds + RING_OFF, xch, g, S, E);
            SEAM(pb + 0);
        }
        if (PH_ON(3) && IN(pb + 1)) {
            PHASE_TID(); unsigned char* ws = WSP();
            const attn_body::AttnTensors AT{(const attn_body::bf16*)(ws + WS_Q), (const attn_body::bf16*)(ws + WS_K), (const attn_body::bf16*)(ws + WS_V), (attn_body::bf16*)(ws + WS_Q)};
            const attn_body::StaticOrder S(G, vcu);
            attn_body::attn_phase<attn_body::StaticOrder>(ptid, (char*)lds_raw + RING_OFF, AT, S, (const float*)(ws + WS_KB), (const float*)(ws + WS_KPART), ARGF(5));
            SEAM(pb + 1);
        }
        if (PH_ON(4) && IN(pb + 2)) {
            PHASE_TID(); unsigned char* ws = WSP(); float* X = (float*)ARGF(22);
            pg8::Gemm g{(const bf16_t*)(ws + WS_Q), (const bf16_t*)(ws + WS_WO) + (size_t)l * DM * DM, DM, DM, DM, nullptr};
            pg8::GridOrder<0> S; S.init(T / 256, DM / 256, G, bx, DM, DM);
            pg8::EpiResid E{l == 0 ? ARGF(0) : (const float*)X, X};
            pg8::gemm_phase<pg8::EpiResid, pg8::GridOrder<0>, false, true>(ptid, lds + RING_OFF, xch, g, S, E);
            SEAM(pb + 2);
        }
        if (PH_ON(5) && IN(pb + 3)) {
            PHASE_TID(); unsigned char* ws = WSP(); float* X = (float*)ARGF(22); bf16_t* XB = (bf16_t*)(ws + WS_XB); const int gw = vcu * NWAVES + wave;
            f32x4 gg[4], bb[4]; row_load(ARGF(6) + (size_t)l * DM, lane, gg); row_load(ARGF(7) + (size_t)l * DM, lane, bb);
            for (int rg = gw; rg < T / 16; rg += NGW)
                for (int r = 0; r < 16; ++r) { const size_t t = (size_t)rg * 16 + r; f32x4 v[4]; row_load(X + t * DM, lane, v); row_layernorm(v, gg, bb);
                    row_store_f32(X + t * DM, lane, v); row_store_bf16(XB + t * DM, lane, v); }
            SEAM(pb + 3);
        }
        if (PH_ON(6) && IN(pb + 4)) {
            PHASE_TID(); unsigned char* ws = WSP();
            pg8::Gemm g{(const bf16_t*)(ws + WS_XB), (const bf16_t*)(ws + WS_WCQ) + (size_t)l * DM * DM, DM, DM, DM, nullptr};
            pg8::GridOrder<0> S; S.init(T / 256, DM / 256, G, bx, DM, DM);
            pg8::EpiBf16S E{(bf16_t*)(ws + WS_Q), DM, C2_CROSS, nullptr, 0, 1};
            pg8::gemm_phase<pg8::EpiBf16S, pg8::GridOrder<0>, false, true>(ptid, lds + RING_OFF, xch, g, S, E);
            SEAM(pb + 4);
        }
        if (PH_ON(7) && IN(pb + 5)) {
            PHASE_TID(); unsigned char* ws = WSP();
            pg8::Gemm g{(const bf16_t*)(ws + WS_Q), (const bf16_t*)(ws + WS_KC) + (size_t)l * TM * DM, DM, DM, 256, nullptr};
            pg8::GridOrder<1> S; S.init(T / 256, 4, G, bx, DM, DM);
            pg8::EpiSoftmax E{(bf16_t*)(ws + WS_K)};
            pg8::gemm_phase<pg8::EpiSoftmax, pg8::GridOrder<1>, false, true>(ptid, lds + RING_OFF, xch, g, S, E);
            SEAM(pb + 5);
        }
        if (PH_ON(8) && IN(pb + 6)) {
            PHASE_TID(); unsigned char* ws = WSP();
            pg8::Gemm g{(const bf16_t*)(ws + WS_K), (const bf16_t*)(ws + WS_VT) + (size_t)l * TM * DM, DM, TM, 256, nullptr};
            pg8::GridOrder<2> S; S.init(T / 256, 4, G, bx, DM, TM);
            pg8::EpiBf16S E{(bf16_t*)(ws + WS_V), DM, 1.0f, nullptr, 0, 1};
            pg8::gemm_phase<pg8::EpiBf16S, pg8::GridOrder<2>, false, true>(ptid, lds + RING_OFF, xch, g, S, E);
            SEAM(pb + 6);
        }
        if (PH_ON(9) && IN(pb + 7)) {
            PHASE_TID(); unsigned char* ws = WSP(); float* X = (float*)ARGF(22);
            pg8::Gemm g{(const bf16_t*)(ws + WS_V), (const bf16_t*)(ws + WS_WCO) + (size_t)l * DM * DM, DM, DM, DM, nullptr};
            pg8::GridOrder<0> S; S.init(T / 256, DM / 256, G, bx, DM, DM);
            pg8::EpiResid E{X, X};
            pg8::gemm_phase<pg8::EpiResid, pg8::GridOrder<0>, false, true>(ptid, lds + RING_OFF, xch, g, S, E);
            SEAM(pb + 7);
        }
        if (PH_ON(10) && IN(pb + 8)) {
            PHASE_TID(); unsigned char* ws = WSP(); float* X = (float*)ARGF(22); bf16_t* XB = (bf16_t*)(ws + WS_XB); const int gw = vcu * NWAVES + wave; gu32* ctl = (gu32*)ws;
            const float* w_router = ARGF(14); const float* b_router = ARGF(15); const float* ln2_g = ARGF(12); const float* ln2_b = ARGF(13);
            int* ASGE = (int*)(ws + WS_ASGE); int* ASGR = (int*)(ws + WS_ASGR); float* ASGG = (float*)(ws + WS_ASGG); int* STOK = (int*)(ws + WS_STOK);
            const int tid = ptid;
            constexpr int RWS = 1028;
            LAS float* wl = (LAS float*)(lds + RING_OFF);
            LAS int* sE = (LAS int*)(lds + RING_OFF + NE * RWS * 4); LAS float* sG = (LAS float*)(sE + 512); LAS int* cntw = (LAS int*)(sG + 512); LAS int* basew = cntw + 256;
            { const float* wr_l = w_router + (size_t)l * DM * NE;
              for (int idx = tid; idx < DM * NE / 4; idx += NWAVES * 64) { const int k = idx >> 3, e4 = (idx & 7) * 4; const f32x4 w4 = *(const f32x4*)(wr_l + (size_t)k * NE + e4);
                  wl[(e4 + 0) * RWS + k] = w4[0]; wl[(e4 + 1) * RWS + k] = w4[1]; wl[(e4 + 2) * RWS + k] = w4[2]; wl[(e4 + 3) * RWS + k] = w4[3]; } }
            __syncthreads();
            gu32* cnt_l = ctl + CW_CNT + l * NE * 64;
            for (int rg = gw; rg < T / 16; rg += NGW) {
#pragma unroll 1
                for (int g4 = 0; g4 < 4; ++g4) {
                    int lo_ = lane; asm volatile("" : "+v"(lo_));
                    const int t0 = rg * 16 + g4 * 4; f32x4 xn[4][4];
                    { f32x4 gg[4], bb[4]; row_load(ln2_g + (size_t)l * DM, lo_, gg); row_load(ln2_b + (size_t)l * DM, lo_, bb);
#pragma unroll
                      for (int r = 0; r < 4; ++r) { const size_t t = (size_t)(t0 + r); row_load(X + t * DM, lo_, xn[r]); row_layernorm(xn[r], gg, bb);
                          row_store_f32(X + t * DM, lo_, xn[r]); row_store_bf16(XB + t * DM, lo_, xn[r]); } }
                    float vv[4]; const int eb = (lo_ >> 1) & 7;
#pragma unroll
                    for (int c = 0; c < 4; ++c) { const LAS float* wlo = wl + c * 8 * RWS; asm volatile("" : "+v"(wlo));
                        float acc[32]; thin_dot<8>(xn, wlo, RWS, lo_, acc); butterfly32(acc, lo_); vv[c] = acc[0] + b_router[l * NE + c * 8 + eb]; }
                    float topv[4]; int tope[4];
#pragma unroll
                    for (int k = 0; k < 4; ++k) { float bv = vv[0]; int be = eb;
#pragma unroll
                        for (int c = 1; c < 4; ++c) { if (vv[c] > bv) { bv = vv[c]; be = c * 8 + eb; } }
#pragma unroll
                        for (int o = 1; o < 16; o <<= 1) { const float ov = __shfl_xor(bv, o); const int oe = __shfl_xor(be, o); const bool take = (ov > bv) || (ov == bv && oe < be); bv = take ? ov : bv; be = take ? oe : be; }
                        topv[k] = bv; tope[k] = be;
#pragma unroll
                        for (int c = 0; c < 4; ++c) if (be == c * 8 + eb) vv[c] = -INFINITY; }
                    const float p1 = __expf(topv[1] - topv[0]), p2 = __expf(topv[2] - topv[0]), p3 = __expf(topv[3] - topv[0]); const float rs = 1.0f / (1.0f + p1 + p2 + p3);
                    const int kk = lo_ & 15;
                    if (kk < 4) { const int me = kk == 0 ? tope[0] : kk == 1 ? tope[1] : kk == 2 ? tope[2] : tope[3]; const float mg = (kk == 0 ? 1.0f : kk == 1 ? p1 : kk == 2 ? p2 : p3) * rs;
                        const int slot = wave * 64 + (g4 * 4 + (lo_ >> 4)) * 4 + kk; sE[slot] = me; sG[slot] = mg; }
                }
                LDS_WAIT();
                int lq_ = lane; asm volatile("" : "+v"(lq_));
                const int my_e = sE[wave * 64 + lq_]; const float my_g = sG[wave * 64 + lq_]; const int my_t = rg * 16 + (lq_ >> 2);
                int lr = 0, mycnt = 0;
#pragma unroll 1
                for (int e = 0; e < NE; ++e) { const unsigned long long m = __ballot(my_e == e); if (my_e == e) lr = __popcll(m & ((1ull << lq_) - 1ull)); if (lq_ == e) mycnt = __popcll(m); }
                if (lq_ < NE) cntw[wave * NE + lq_] = mycnt;
                __syncthreads();
                int tq_ = tid; asm volatile("" : "+v"(tq_));
                if (tq_ < NE) { int tot = 0; int c8[NWAVES];
#pragma unroll
                    for (int w = 0; w < NWAVES; ++w) { c8[w] = cntw[w * NE + tq_]; tot += c8[w]; }
                    int base = 0; if (tot > 0) base = (int)__hip_atomic_fetch_add(cnt_l + tq_ * 64, (unsigned)tot, __ATOMIC_RELAXED, __HIP_MEMORY_SCOPE_AGENT);
#pragma unroll
                    for (int w = 0; w < NWAVES; ++w) { basew[w * NE + tq_] = base; base += c8[w]; } }
                __syncthreads();
                const int rank = basew[wave * NE + my_e] + lr;
                ASGE[(size_t)my_t * 4 + (lq_ & 3)] = my_e; ASGR[(size_t)my_t * 4 + (lq_ & 3)] = rank; ASGG[(size_t)my_t * 4 + (lq_ & 3)] = my_g;
                STOK[(size_t)my_e * ECAP + rank] = my_t;
                __syncthreads();
            }
            SEAM(pb + 8);
        }
        if ((PH_ON(11) && IN(pb + 9)) || (PH_ON(12) && IN(pb + 10)) || (PH_ON(13) && IN(pb + 11))) {
            PHASE_TID(); gu32* ctl = (gu32*)WSP();
            __syncthreads();
            if (ptid < NE) CNT[ptid] = (int)__hip_atomic_load(ctl + CW_CNT + (l * NE + ptid) * 64, __ATOMIC_RELAXED, __HIP_MEMORY_SCOPE_AGENT);
            __syncthreads();
            if (ptid == 0) { int a = 0; for (int e = 0; e < NE; ++e) { TP[e] = a; a += (CNT[e] + 255) >> 8; } TP[NE] = a; }
            __syncthreads();
        }
        if (PH_ON(11) && IN(pb + 9)) {
            PHASE_TID(); unsigned char* ws = WSP();
            pg8::Gemm g{(const bf16_t*)(ws + WS_XB), (const bf16_t*)(ws + WS_WGU) + (size_t)l * NE * 2048 * DM, DM, DM, DM, (const int*)(ws + WS_STOK)};
            pg8::MoeOrder<8, true> S; S.init(TP, CNT, G, bx);
            pg8::EpiSwiglu E{(bf16_t*)(ws + WS_ACT), ARGF(17) + (size_t)l * NE * 2048};
            pg8::gemm_phase<pg8::EpiSwiglu, pg8::MoeOrder<8, true>, true, true>(ptid, lds + RING_OFF, xch, g, S, E);
            SEAM(pb + 9);
        }
        if (PH_ON(12) && IN(pb + 10)) {
            PHASE_TID(); unsigned char* ws = WSP();
            pg8::Gemm g{(const bf16_t*)(ws + WS_ACT), (const bf16_t*)(ws + WS_WD) + (size_t)l * NE * DM * DM, DM, DM, DM, nullptr};
            pg8::MoeOrder<4, false> S; S.init(TP, CNT, G, bx);
            pg8::EpiBf16S E{(bf16_t*)(ws + WS_YEXP), DM, 1.0f, ARGF(19) + (size_t)l * NE * DM, DM, 256};
            pg8::gemm_phase<pg8::EpiBf16S, pg8::MoeOrder<4, false>, false, true>(ptid, lds + RING_OFF, xch, g, S, E);
            SEAM(pb + 10);
        }
        if (PH_ON(13) && IN(pb + 11)) {
            PHASE_TID(); unsigned char* ws = WSP(); float* X = (float*)ARGF(22); const int gw = vcu * NWAVES + wave;
            bf16_t* XB = (bf16_t*)(ws + WS_XB); const int* ASGE = (const int*)(ws + WS_ASGE); const int* ASGR = (const int*)(ws + WS_ASGR); const float* ASGG = (const float*)(ws + WS_ASGG);
            const bf16_t* YEXP = (const bf16_t*)(ws + WS_YEXP); float* LOGF = (float*)(ws + WS_LOGF); const float* b_forget = ARGF(3);
            LAS float* wf = (LAS float*)(lds + RING_OFF);
            if (l + 1 < NL) { load_wf(ARGF(2) + (size_t)(l + 1) * DM * IN_COLS, wf, ptid); __syncthreads(); }
            f32x4 gg[4], bb[4]; row_load(ARGF(20) + (size_t)l * DM, lane, gg); row_load(ARGF(21) + (size_t)l * DM, lane, bb);
            for (int rg = gw; rg < T / 16; rg += NGW)
                for (int g4 = 0; g4 < 4; ++g4) { const int t0 = rg * 16 + g4 * 4; f32x4 xn[4][4];
#pragma unroll
                    for (int r = 0; r < 4; ++r) { const size_t t = (size_t)(t0 + r); row_load(X + t * DM, lane, xn[r]);
#pragma unroll
                        for (int j = 0; j < 4; ++j) xn[r][j] = xn[r][j] * DN_ALPHA;
#pragma unroll
                        for (int k = 0; k < 4; ++k) { const int e = ASGE[t * 4 + k], rk = ASGR[t * 4 + k]; const float gt = ASGG[t * 4 + k];
                            const GAS u32x2* yr = (const GAS u32x2*)(YEXP + ((size_t)TP[e] * 256 + rk) * DM) + lane;
#pragma unroll
                            for (int j = 0; j < 4; ++j) { const u32x2 w = yr[64 * j];
                                xn[r][j][0] += gt * __uint_as_float(w.x << 16); xn[r][j][1] += gt * __uint_as_float(w.x & 0xffff0000u);
                                xn[r][j][2] += gt * __uint_as_float(w.y << 16); xn[r][j][3] += gt * __uint_as_float(w.y & 0xffff0000u); } }
                        row_layernorm(xn[r], gg, bb); row_store_f32(X + t * DM, lane, xn[r]); row_store_bf16(XB + t * DM, lane, xn[r]); }
                    if (l + 1 < NL) forget_rows(xn, wf, b_forget + (l + 1) * 8, LOGF, t0, lane); }
            __syncthreads();
            SEAM(pb + 11);
        }
    }
#undef IN
#undef BOTH
#undef SEAM
}

#ifndef MK_PER_PHASE
#define MK_PER_PHASE 1
#endif
extern "C" void kernel_launch(void* const* d_in, const int* in_sizes, int n_in, void* d_out, int out_size, void* d_ws, size_t ws_size, hipStream_t stream) {
    static int grid = 0;
    if (grid == 0) {
        if (n_in != 22 || in_sizes[0] != T * DM || out_size != T * DM || ws_size < WS_END) {
            fprintf(stderr, "kernel_launch: built for 22 inputs, x/out of %d floats, >= %zu bytes of workspace; got n_in %d, in0 %d, out %d, ws %zu; nothing launched\n", T * DM, (size_t)WS_END, n_in, n_in > 0 ? in_sizes[0] : -1, out_size, ws_size); grid = -1; return; }
        int dev = 0, cus = 0, per_cu = 0;
        if (hipGetDevice(&dev) != hipSuccess || hipDeviceGetAttribute(&cus, hipDeviceAttributeMultiprocessorCount, dev) != hipSuccess) { fprintf(stderr, "kernel_launch: device query failed\n"); grid = -1; return; }
        if (hipFuncSetAttribute((const void*)skel_fwd, hipFuncAttributeMaxDynamicSharedMemorySize, LDS_BYTES) != hipSuccess) { fprintf(stderr, "kernel_launch: hipFuncSetAttribute failed\n"); grid = -1; return; }
        if (hipOccupancyMaxActiveBlocksPerMultiprocessor(&per_cu, (const void*)skel_fwd, NWAVES * 64, LDS_BYTES) != hipSuccess || per_cu < 1)
            fprintf(stderr, "kernel_launch: note: occupancy query reports %d workgroups per CU\n", per_cu);
        (void)hipGetLastError();
        grid = cus;
    }
    if (grid < 0) return;
    if (hipMemsetAsync((char*)d_ws + WS_CTL, 0, CTL_ZERO_BYTES, stream) != hipSuccess) { fprintf(stderr, "kernel_launch: memset failed\n"); return; }
    Args a{};
    for (int i = 0; i < 22; ++i) a.in[i] = (const float*)d_in[i];
    a.out = (float*)d_out; a.ws = (unsigned char*)d_ws;
#if MK_PER_PHASE
    for (int p = 0; p < NPHASE; ++p) { a.ph_lo = p; a.ph_hi = p + 1; hipLaunchKernelGGL(skel_fwd, dim3(grid), dim3(NWAVES * 64), LDS_BYTES, stream, a); }
#else
    a.ph_lo = 0; a.ph_hi = NPHASE; hipLaunchKernelGGL(skel_fwd, dim3(grid), dim3(NWAVES * 64), LDS_BYTES, stream, a);
#endif
    const hipError_t le = hipPeekAtLastError();
    if (le != hipSuccess) fprintf(stderr, "kernel_launch: launch failed: %s\n", hipGetErrorName(le));
}
```

```cpp
#include <hip/hip_runtime.h>
#include <cstdio>
#include <cstdint>
#include <cmath>

#define GAS __attribute__((address_space(1)))
#define LAS __attribute__((address_space(3)))
typedef unsigned short bf16_t;
typedef short bf16x8 __attribute__((ext_vector_type(8)));
typedef float f32x4 __attribute__((ext_vector_type(4)));
typedef float f32x2 __attribute__((ext_vector_type(2)));
typedef float f32x16 __attribute__((ext_vector_type(16)));
typedef unsigned u32x4 __attribute__((ext_vector_type(4)));
typedef unsigned u32x2 __attribute__((ext_vector_type(2)));
typedef short s16x4 __attribute__((ext_vector_type(4)));

constexpr int NB = 16, SEQ = 2048, DM = 1024, NL = 4, T = NB * SEQ;
constexpr int NMEM = 256, TM = NB * NMEM;
constexpr int NE = 32, TOPK = 4, TK = T * TOPK;
constexpr int IN_COLS = 3080, IN_N = 3072;
constexpr int FCOL = 1536;
constexpr float LN_EPS = 1e-5f;
constexpr float DN_ALPHA = 1.681792830507429f;
constexpr float LOG2E = 1.4426950408889634f;
constexpr float C2_ATT = 0.125f * LOG2E;
constexpr float C2_CROSS = 0.0625f * LOG2E;
constexpr int ECAP = 32768;
constexpr int MAXTILES = 544;

__device__ __forceinline__ unsigned cvt_pk_bf16(float lo, float hi) { unsigned r; asm volatile("v_cvt_pk_bf16_f32 %0, %1, %2" : "=v"(r) : "v"(lo), "v"(hi)); return r; }
__device__ __forceinline__ float bf2f(unsigned short b) { return __uint_as_float((unsigned)b << 16); }
#include <hip/hip_bf16.h>
typedef GAS unsigned gu32;
typedef GAS unsigned long long gu64;
#define RLX_AGENT __ATOMIC_RELAXED, __HIP_MEMORY_SCOPE_AGENT
namespace pg8 {
constexpr int BM = 256, BK = 64, HALF = 128, HTB = HALF * BK * 2  , STAGE_BYTES = 8 * HTB, NXCD = 8, WGM = 8;

__host__ __device__ __forceinline__ int lds_byte(int r, int c) { const int st = (r >> 4) * 2 + (c >> 5), rr = r & 15, cc = c & 31, ob = rr * 64 + cc * 2; return st * 1024 + (ob ^ (((ob >> 9) & 1) << 5)); }
__host__ __device__ __forceinline__ void stage_rc(int b, int& R, int& C) { const int st = b / 1024, sb = b % 1024, swz = sb ^ (((sb >> 9) & 1) << 5); R = (st >> 1) * 16 + swz / 64; C = (st & 1) * 32 + (swz % 64) / 2; }
__host__ __device__ __forceinline__ int perm32(int rho) { const int n = rho >> 4, i = rho & 15; return 8 * (i >> 2) + 4 * n + (i & 3); }

struct Unit { long abyte, bbyte; int orow, ocol, aux, grow, gcnt; };
struct Gemm { const bf16_t* A; const bf16_t* Bt; int lda, ldb, K; const int* gtok; };

__device__ __forceinline__ int xcd_chunk(int L, int nwg) { const int q = nwg / NXCD, r = nwg % NXCD, xcd = L % NXCD, off = L / NXCD; return (xcd < r ? xcd * (q + 1) : r * (q + 1) + (xcd - r) * q) + off; }

template <int MODE> struct GridOrder {
    int nM, nN, nwg, G, c, lda, ldb;
    __device__ __forceinline__ void init(int nM_, int nN_, int G_, int c_, int lda_, int ldb_) { nM = nM_; nN = nN_; nwg = nM * nN; G = G_; c = c_; lda = lda_; ldb = ldb_; }
    __device__ __forceinline__ bool next(int i, Unit& u) const {
        const long L = (long)i * G + c; if (L >= nwg) return false;
        const int wgid = xcd_chunk((int)L, nwg);
        const int nig = WGM * nN, gid = wgid / nig, fm = gid * WGM, gsz = (nM - fm) < WGM ? (nM - fm) : WGM;
        const int pm = fm + ((wgid % nig) % gsz), pn = (wgid % nig) / gsz;
        u.orow = pm * BM; u.ocol = pn * BM; u.aux = pn; u.grow = 0; u.gcnt = BM;
        if (MODE == 0) { u.abyte = (long)pm * BM * lda * 2; u.bbyte = (long)pn * BM * ldb * 2; }
        else { const int b = pm >> 3; u.abyte = (long)pm * BM * lda * 2 + pn * 512;
               u.bbyte = (MODE == 1) ? ((long)b * 256 * ldb + pn * 256) * 2 : ((long)pn * 256 * ldb + b * 256) * 2; }
        return true;
    }
};
template <int NPN, bool GATHER> struct MoeOrder {
    const LAS int* tp; const LAS int* cnt; int nwg, G, c;
    __device__ __forceinline__ void init(const LAS int* tp_, const LAS int* cnt_, int G_, int c_) { tp = tp_; cnt = cnt_; G = G_; c = c_; nwg = __builtin_amdgcn_readfirstlane(tp_[32]) * NPN; }
    __device__ __forceinline__ bool next(int i, Unit& u) const {
        const long L = (long)i * G + c; if (L >= nwg) return false;
        const int wgid = xcd_chunk((int)L, nwg);
        int e = 0;
#pragma unroll
        for (int k = 16; k >= 1; k >>= 1) { const int v = __builtin_amdgcn_readfirstlane(tp[e + k]); if (v * NPN <= wgid) e += k; }
        const int t0 = __builtin_amdgcn_readfirstlane(tp[e]), t1 = __builtin_amdgcn_readfirstlane(tp[e + 1]), ce = __builtin_amdgcn_readfirstlane(cnt[e]);
        const int r = wgid - t0 * NPN, nte = t1 - t0, j = r % nte, pn = r / nte;
        u.aux = e; u.grow = e * ECAP + j * BM; u.gcnt = (ce - j * BM) < BM ? (ce - j * BM) : BM;
        u.orow = (t0 + j) * BM; u.ocol = pn;
        u.abyte = GATHER ? 0 : (long)(t0 + j) * BM * DM * 2;
        u.bbyte = (long)(e * NPN + pn) * BM * DM * 2;
        return true;
    }
};

struct EpiCtx { int wr, wc, fr, fq, wid, lane; LAS unsigned char* xch; };

struct EpiQKV {
    static constexpr bool PERM = true;
    bf16_t *Q, *K, *V; float* kpart;
    __device__ __forceinline__ void operator()(const f32x4 (&acc)[2][2][4][2], const Unit& u, const EpiCtx& c) const {
        const int pn = u.aux, ts = (pn >> 1) % 3, grp = pn / 6;
        bf16_t* base = (ts == 0) ? Q : ((ts == 1) ? K : V);
        const float sc = (ts == 0) ? C2_ATT : 1.f;
        const int row0 = u.orow + c.wr * 64 + c.fr, col0 = grp * 512 + (pn & 1) * 256 + c.wc * 32 + 8 * c.fq;
#pragma unroll
        for (int ai = 0; ai < 2; ++ai)
#pragma unroll
            for (int m = 0; m < 4; ++m) { bf16_t* rowp = base + (size_t)(row0 + ai * HALF + m * 16) * DM + col0;
#pragma unroll
                for (int bj = 0; bj < 2; ++bj) { const f32x4 v0 = acc[ai][bj][m][0] * sc, v1 = acc[ai][bj][m][1] * sc;
                    u32x4 w; w.x = cvt_pk_bf16(v0[0], v0[1]); w.y = cvt_pk_bf16(v0[2], v0[3]); w.z = cvt_pk_bf16(v1[0], v1[1]); w.w = cvt_pk_bf16(v1[2], v1[3]);
                    *(u32x4*)(rowp + bj * HALF) = w; } }
        if (pn == 8 || pn == 9) {
#pragma unroll
            for (int bj = 0; bj < 2; ++bj)
#pragma unroll
                for (int n = 0; n < 2; ++n) { f32x4 s = (f32x4){0.f, 0.f, 0.f, 0.f};
#pragma unroll
                    for (int ai = 0; ai < 2; ++ai)
#pragma unroll
                        for (int m = 0; m < 4; ++m) s += acc[ai][bj][m][n];
#pragma unroll
                    for (int o = 1; o < 16; o <<= 1) { s[0] += __shfl_xor(s[0], o); s[1] += __shfl_xor(s[1], o); s[2] += __shfl_xor(s[2], o); s[3] += __shfl_xor(s[3], o); }
                    if (c.fr == 0) *(f32x4*)(kpart + (size_t)((u.orow >> 8) * 2 + c.wr) * 512 + (pn - 8) * 256 + bj * HALF + c.wc * 32 + 8 * c.fq + 4 * n) = s; }
        }
    }
};
struct EpiResid {
    static constexpr bool PERM = false;
    const float* res; float* out;
    __device__ __forceinline__ void operator()(const f32x4 (&acc)[2][2][4][2], const Unit& u, const EpiCtx& c) const {
        const int row0 = u.orow + c.wr * 64 + c.fr, col0 = u.ocol + c.wc * 32 + 4 * c.fq;
#pragma unroll
        for (int ai = 0; ai < 2; ++ai)
#pragma unroll
            for (int m = 0; m < 4; ++m) { const size_t off = (size_t)(row0 + ai * HALF + m * 16) * DM + col0;
#pragma unroll
                for (int bj = 0; bj < 2; ++bj)
#pragma unroll
                    for (int n = 0; n < 2; ++n) { const f32x4 r = *(const f32x4*)(res + off + bj * HALF + n * 16); *(f32x4*)(out + off + bj * HALF + n * 16) = r * DN_ALPHA + acc[ai][bj][m][n]; } }
    }
};
struct EpiBf16S {
    static constexpr bool PERM = true;
    bf16_t* O; int ldc; float scale; const float* bias; int bstride; int cmul;
    __device__ __forceinline__ void operator()(const f32x4 (&acc)[2][2][4][2], const Unit& u, const EpiCtx& c) const {
        const int row0 = u.orow + c.wr * 64 + c.fr, col0 = u.ocol * cmul + c.wc * 32 + 8 * c.fq;
        f32x4 bv[2][2];
#pragma unroll
        for (int bj = 0; bj < 2; ++bj)
#pragma unroll
            for (int n = 0; n < 2; ++n) bv[bj][n] = bias ? *(const f32x4*)(bias + (size_t)u.aux * bstride + col0 + bj * HALF + 4 * n) : (f32x4){0.f, 0.f, 0.f, 0.f};
#pragma unroll
        for (int ai = 0; ai < 2; ++ai)
#pragma unroll
            for (int m = 0; m < 4; ++m) { bf16_t* rowp = O + (size_t)(row0 + ai * HALF + m * 16) * ldc + col0;
#pragma unroll
                for (int bj = 0; bj < 2; ++bj) { const f32x4 v0 = (acc[ai][bj][m][0] + bv[bj][0]) * scale, v1 = (acc[ai][bj][m][1] + bv[bj][1]) * scale;
                    u32x4 w; w.x = cvt_pk_bf16(v0[0], v0[1]); w.y = cvt_pk_bf16(v0[2], v0[3]); w.z = cvt_pk_bf16(v1[0], v1[1]); w.w = cvt_pk_bf16(v1[2], v1[3]);
                    *(u32x4*)(rowp + bj * HALF) = w; } }
    }
};
struct EpiSwiglu {
    static constexpr bool PERM = true;
    bf16_t* O; const float* bias;
    __device__ __forceinline__ void operator()(const f32x4 (&acc)[2][2][4][2], const Unit& u, const EpiCtx& c) const {
        const int row0 = u.orow + c.wr * 64 + c.fr, col0 = u.ocol * HALF + c.wc * 32 + 8 * c.fq;
        const float* bp = bias + (size_t)u.aux * 2048 + col0;
        f32x4 bg[2], bu[2];
#pragma unroll
        for (int n = 0; n < 2; ++n) { bg[n] = *(const f32x4*)(bp + 4 * n); bu[n] = *(const f32x4*)(bp + 1024 + 4 * n); }
#pragma unroll
        for (int ai = 0; ai < 2; ++ai)
#pragma unroll
            for (int m = 0; m < 4; ++m) { float o[8];
#pragma unroll
                for (int n = 0; n < 2; ++n)
#pragma unroll
                    for (int i = 0; i < 4; ++i) { float gv = acc[ai][0][m][n][i] + bg[n][i], uv = acc[ai][1][m][n][i] + bu[n][i];
                        gv = fminf(gv, 7.0f); uv = fminf(fmaxf(uv, -7.0f), 7.0f);
                        const float sg = __builtin_amdgcn_rcpf(1.0f + __builtin_amdgcn_exp2f(gv * (-1.702f * LOG2E)));
                        o[n * 4 + i] = (uv + 1.0f) * (gv * sg); }
                u32x4 w; w.x = cvt_pk_bf16(o[0], o[1]); w.y = cvt_pk_bf16(o[2], o[3]); w.z = cvt_pk_bf16(o[4], o[5]); w.w = cvt_pk_bf16(o[6], o[7]);
                *(u32x4*)(O + (size_t)(row0 + ai * HALF + m * 16) * DM + col0) = w; }
    }
};
struct EpiSoftmax {
    static constexpr bool PERM = true;
    bf16_t* O;
    __device__ __forceinline__ void operator()(f32x4 (&acc)[2][2][4][2], const Unit& u, const EpiCtx& c0) const {
        EpiCtx c = c0; asm volatile("" : "+v"(c.fr), "+v"(c.fq));
        LAS float* MX = (LAS float*)c.xch;
        LAS float* SM = (LAS float*)(c.xch + 4096);
#pragma unroll
        for (int ai = 0; ai < 2; ++ai)
#pragma unroll
            for (int m = 0; m < 4; ++m) { float mx = -INFINITY;
#pragma unroll
                for (int bj = 0; bj < 2; ++bj)
#pragma unroll
                    for (int n = 0; n < 2; ++n) { const f32x4 x = acc[ai][bj][m][n]; mx = fmaxf(mx, fmaxf(fmaxf(x[0], x[1]), fmaxf(x[2], x[3]))); }
                mx = fmaxf(mx, __shfl_xor(mx, 16)); mx = fmaxf(mx, __shfl_xor(mx, 32));
                if (c.fq == 0) MX[(ai * HALF + c.wr * 64 + m * 16 + c.fr) * 4 + c.wc] = mx; }
        asm volatile("s_waitcnt lgkmcnt(0)" ::: "memory"); __builtin_amdgcn_s_barrier(); asm volatile("" ::: "memory");
#pragma unroll
        for (int ai = 0; ai < 2; ++ai)
#pragma unroll
            for (int m = 0; m < 4; ++m) { const int r = ai * HALF + c.wr * 64 + m * 16 + c.fr; const f32x4 mm = *(const LAS f32x4*)(MX + r * 4);
                const float mx = fmaxf(fmaxf(mm[0], mm[1]), fmaxf(mm[2], mm[3])); float s = 0.f;
#pragma unroll
                for (int bj = 0; bj < 2; ++bj)
#pragma unroll
                    for (int n = 0; n < 2; ++n) { f32x4 x = acc[ai][bj][m][n];
                        x[0] = __builtin_amdgcn_exp2f(x[0] - mx); x[1] = __builtin_amdgcn_exp2f(x[1] - mx); x[2] = __builtin_amdgcn_exp2f(x[2] - mx); x[3] = __builtin_amdgcn_exp2f(x[3] - mx);
                        s += (x[0] + x[1]) + (x[2] + x[3]); acc[ai][bj][m][n] = x; }
                s += __shfl_xor(s, 16); s += __shfl_xor(s, 32);
                if (c.fq == 0) SM[r * 4 + c.wc] = s; __builtin_amdgcn_sched_barrier(0); }
        asm volatile("s_waitcnt lgkmcnt(0)" ::: "memory"); __builtin_amdgcn_s_barrier(); asm volatile("" ::: "memory");
        const int row0 = u.orow + c.wr * 64 + c.fr, col0 = u.ocol + c.wc * 32 + 8 * c.fq;
#pragma unroll
        for (int ai = 0; ai < 2; ++ai)
#pragma unroll
            for (int m = 0; m < 4; ++m) { const int r = ai * HALF + c.wr * 64 + m * 16 + c.fr; const f32x4 ss = *(const LAS f32x4*)(SM + r * 4);
                const float rl = 1.0f / ((ss[0] + ss[1]) + (ss[2] + ss[3]));
                bf16_t* rowp = O + (size_t)(row0 + ai * HALF + m * 16) * DM + col0;
#pragma unroll
                for (int bj = 0; bj < 2; ++bj) { const f32x4 v0 = acc[ai][bj][m][0] * rl, v1 = acc[ai][bj][m][1] * rl;
                    u32x4 w; w.x = cvt_pk_bf16(v0[0], v0[1]); w.y = cvt_pk_bf16(v0[2], v0[3]); w.z = cvt_pk_bf16(v1[0], v1[1]); w.w = cvt_pk_bf16(v1[2], v1[3]);
                    *(u32x4*)(rowp + bj * HALF) = w; } __builtin_amdgcn_sched_barrier(0); }
    }
};

template <class Epi, class Sched, bool GATHER, bool ALIGN_EPI>
__device__ __forceinline__ void gemm_phase(int tid, LAS unsigned char* lds, LAS unsigned char* xch, const Gemm g, const Sched& S, const Epi& E) {
    const int wid = __builtin_amdgcn_readfirstlane(tid >> 6), lane = tid & 63, wr = wid >> 2, wc = wid & 3, fr = lane & 15, fq = lane >> 4;
    int Kv = g.K; asm volatile("" : "+s"(Kv));
    const int nt = Kv / BK;
    EpiCtx ctx; ctx.wr = wr; ctx.wc = wc; ctx.fr = fr; ctx.fq = fq; ctx.wid = wid; ctx.lane = lane; ctx.xch = xch;
    unsigned oB[2], oAc[2][2], oAn[2][2];
#pragma unroll
    for (int i = 0; i < 2; ++i) { int R, C; stage_rc(tid * 16 + i * 8192, R, C); const int Rb = Epi::PERM ? ((R & ~31) + perm32(R & 31)) : R;
        oB[i] = (unsigned)(Rb * g.ldb + C) * 2u;
        oAc[0][i] = (unsigned)(R * g.lda + C) * 2u; oAc[1][i] = oAc[0][i] + (unsigned)(HALF * g.lda * 2); oAn[0][i] = oAc[0][i]; oAn[1][i] = oAc[1][i]; }
    const size_t kstep = (size_t)(BK * 2);
    const size_t hstepB = (size_t)HALF * g.ldb * 2;
    const unsigned ldsw = (unsigned)wid * 1024u;
    const int aoff = lds_byte(wr * 64 + fr, fq * 8), boff = lds_byte(wc * 32 + fr, fq * 8);
#define PG8_SA(b, h) (((b) * 2 + (h)) * HTB)
#define PG8_SB(b, h) ((4 + (b) * 2 + (h)) * HTB)
#define PG8_STAGE(bufoff, gbase, o0, o1) do { \
        __builtin_amdgcn_global_load_lds((const unsigned*)((const char*)(gbase) + (o0)), (LAS unsigned*)(lds + (bufoff) + ldsw), 16, 0, 0); \
        __builtin_amdgcn_global_load_lds((const unsigned*)((const char*)(gbase) + (o1)), (LAS unsigned*)(lds + (bufoff) + ldsw + 8192), 16, 0, 0); } while (0)
#define PG8_STAGE_B(bufoff, gbase) PG8_STAGE(bufoff, gbase, oB[0], oB[1])
#define PG8_LDA(dst, b, h) do { _Pragma("unroll") for (int m = 0; m < 4; ++m) _Pragma("unroll") for (int k = 0; k < 2; ++k) dst[m][k] = *(const LAS bf16x8*)(lds + PG8_SA(b, h) + aoff + m * 2048 + k * 1024); } while (0)
#define PG8_LDB(dst, b, h) do { _Pragma("unroll") for (int n = 0; n < 2; ++n) _Pragma("unroll") for (int k = 0; k < 2; ++k) dst[n][k] = *(const LAS bf16x8*)(lds + PG8_SB(b, h) + boff + n * 2048 + k * 1024); } while (0)
#define PG8_MMA(ai, bj, At, Bt) do { __builtin_amdgcn_s_setprio(1); _Pragma("unroll") for (int m = 0; m < 4; ++m) _Pragma("unroll") for (int n = 0; n < 2; ++n) _Pragma("unroll") for (int k = 0; k < 2; ++k) \
        acc[ai][bj][m][n] = __builtin_amdgcn_mfma_f32_16x16x32_bf16(Bt[n][k], At[m][k], acc[ai][bj][m][n], 0, 0, 0); __builtin_amdgcn_s_setprio(0); } while (0)
#define PG8_WAIT_V(n) asm volatile("s_waitcnt vmcnt(" #n ")" ::: "memory")
#define PG8_WAIT_L(n) asm volatile("s_waitcnt lgkmcnt(" #n ")" ::: "memory")
#define PG8_BAR __builtin_amdgcn_s_barrier()
#define PG8_SCHED __builtin_amdgcn_sched_barrier(0)
#define PG8_TOK_LOAD(U, tk) do { int t_ = tid; asm volatile("" : "+v"(t_)); _Pragma("unroll") for (int i = 0; i < 2; ++i) { int R_, C_; stage_rc(t_ * 16 + i * 8192, R_, C_); _Pragma("unroll") for (int h = 0; h < 2; ++h) { \
        const int r_ = h * HALF + R_; tk[h][i] = (r_ < (U).gcnt) ? ((const GAS int*)g.gtok)[(U).grow + r_] : 0; } } } while (0)
#define PG8_TOK_OFF(tk, set) do { int t_ = tid; asm volatile("" : "+v"(t_)); _Pragma("unroll") for (int i = 0; i < 2; ++i) { int R_, C_; stage_rc(t_ * 16 + i * 8192, R_, C_); _Pragma("unroll") for (int h = 0; h < 2; ++h) { \
        set[h][i] = (unsigned)(tk[h][i] * g.lda + C_) * 2u; asm volatile("" : "+v"(set[h][i])); } } } while (0)
    Unit cur, nxt, nn; int ui = 0;
    if (!S.next(0, cur)) return;
    bool has_next = S.next(1, nxt);
    if constexpr (GATHER) {
        int tk[2][2]; PG8_TOK_LOAD(cur, tk); PG8_TOK_OFF(tk, oAc);
        if (has_next) { PG8_TOK_LOAD(nxt, tk); PG8_TOK_OFF(tk, oAn); }
        else {
#pragma unroll
            for (int h = 0; h < 2; ++h)
#pragma unroll
                for (int i = 0; i < 2; ++i) oAn[h][i] = oAc[h][i]; }
    }
    f32x4 acc[2][2][4][2];
#pragma unroll
    for (int a = 0; a < 2; ++a)
#pragma unroll
        for (int b = 0; b < 2; ++b)
#pragma unroll
            for (int m = 0; m < 4; ++m)
#pragma unroll
                for (int n = 0; n < 2; ++n) acc[a][b][m][n] = (f32x4){0.f, 0.f, 0.f, 0.f};
    bf16x8 At[4][2], B0[2][2], B1[2][2];
    const char* cA = (const char*)g.A + cur.abyte; const char* cB = (const char*)g.Bt + cur.bbyte;
    PG8_STAGE_B(PG8_SB(0, 0), cB); PG8_STAGE_B(PG8_SB(0, 1), cB + hstepB); PG8_STAGE(PG8_SA(0, 0), cA, oAc[0][0], oAc[0][1]); PG8_STAGE(PG8_SA(0, 1), cA, oAc[1][0], oAc[1][1]);
    if (wr == 1) PG8_BAR;
    PG8_WAIT_V(2); PG8_BAR;
    PG8_STAGE_B(PG8_SB(1, 0), cB + kstep); PG8_STAGE(PG8_SA(1, 0), cA + kstep, oAc[0][0], oAc[0][1]); PG8_STAGE_B(PG8_SB(1, 1), cB + hstepB + kstep);
    PG8_WAIT_V(6); PG8_BAR;
    for (;;) {
        bool has_nn = false;
        if (has_next) has_nn = S.next(ui + 2, nn);
        int tkp[2][2];
        if constexpr (GATHER) { if (has_nn) { PG8_TOK_LOAD(nn, tkp); } }
        const char* nA = has_next ? (const char*)g.A + nxt.abyte : cA; const char* nB = has_next ? (const char*)g.Bt + nxt.bbyte : cB;
        for (int t = 0; t < nt; t += 2) {
            const bool last = (t == nt - 2);
            const char* a1 = cA + (size_t)(t + 1) * kstep;
            const char* a2 = last ? nA : cA + (size_t)(t + 2) * kstep; const char* b2 = last ? nB : cB + (size_t)(t + 2) * kstep;
            const char* a3 = a2 + kstep; const char* b3 = b2 + kstep;
            unsigned o2[2][2];
#pragma unroll
            for (int h = 0; h < 2; ++h)
#pragma unroll
                for (int i = 0; i < 2; ++i) o2[h][i] = GATHER ? (last ? oAn[h][i] : oAc[h][i]) : oAc[h][i];
            PG8_LDB(B0, 0, 0); PG8_LDB(B1, 0, 1); PG8_SCHED; PG8_LDA(At, 0, 0); PG8_STAGE(PG8_SA(1, 1), a1, oAc[1][0], oAc[1][1]);
            PG8_WAIT_V(8); PG8_WAIT_L(0); PG8_BAR; PG8_MMA(0, 0, At, B0); PG8_MMA(0, 1, At, B1); PG8_BAR; PG8_SCHED;
            PG8_LDA(At, 0, 1); PG8_STAGE_B(PG8_SB(0, 0), b2); PG8_STAGE_B(PG8_SB(0, 1), b2 + hstepB); PG8_STAGE(PG8_SA(0, 0), a2, o2[0][0], o2[0][1]);
            PG8_WAIT_V(8); PG8_WAIT_L(0); PG8_BAR; PG8_MMA(1, 0, At, B0); PG8_MMA(1, 1, At, B1); PG8_BAR; PG8_SCHED;
            PG8_LDB(B0, 1, 0); PG8_LDB(B1, 1, 1); PG8_SCHED; PG8_LDA(At, 1, 0); PG8_STAGE(PG8_SA(0, 1), a2, o2[1][0], o2[1][1]);
            PG8_WAIT_V(8); PG8_WAIT_L(0); PG8_BAR; PG8_MMA(0, 0, At, B0); PG8_MMA(0, 1, At, B1); PG8_BAR; PG8_SCHED;
            PG8_LDA(At, 1, 1); PG8_STAGE_B(PG8_SB(1, 0), b3); PG8_STAGE_B(PG8_SB(1, 1), b3 + hstepB); PG8_STAGE(PG8_SA(1, 0), a3, o2[0][0], o2[0][1]);
            PG8_WAIT_V(8); PG8_WAIT_L(0); PG8_BAR; PG8_MMA(1, 0, At, B0); PG8_MMA(1, 1, At, B1); PG8_BAR; PG8_SCHED;
        }
        if constexpr (ALIGN_EPI) { if (wr == 0) PG8_BAR; }
        E(acc, cur, ctx);
        if (!has_next) break;
#pragma unroll
        for (int a = 0; a < 2; ++a)
#pragma unroll
            for (int b = 0; b < 2; ++b)
#pragma unroll
                for (int m = 0; m < 4; ++m)
#pragma unroll
                    for (int n = 0; n < 2; ++n) acc[a][b][m][n] = (f32x4){0.f, 0.f, 0.f, 0.f};
        cur = nxt; cA = nA; cB = nB; ++ui; nxt = nn; has_next = has_nn;
        if constexpr (GATHER) {
#pragma unroll
            for (int h = 0; h < 2; ++h)
#pragma unroll
                for (int i = 0; i < 2; ++i) oAc[h][i] = oAn[h][i];
            if (has_next) { PG8_TOK_OFF(tkp, oAn); }
        }
        if constexpr (ALIGN_EPI) { if (wr == 1) PG8_BAR; }
    }
    PG8_WAIT_V(0);
    if constexpr (!ALIGN_EPI) { if (wr == 0) PG8_BAR; }
    PG8_BAR;
#undef PG8_SA
#undef PG8_SB
#undef PG8_STAGE
#undef PG8_STAGE_B
#undef PG8_LDA
#undef PG8_LDB
#undef PG8_MMA
#undef PG8_WAIT_V
#undef PG8_WAIT_L
#undef PG8_BAR
#undef PG8_SCHED
#undef PG8_TOK_LOAD
#undef PG8_TOK_OFF
}
}
namespace attn_body {
using bf16=__hip_bfloat16;
using bf16x8=__attribute__((ext_vector_type(8)))short;
using s16x4=__attribute__((ext_vector_type(4)))short;
using f32x16=__attribute__((ext_vector_type(16)))float;
using u32x4=__attribute__((ext_vector_type(4)))unsigned;
constexpr int BATCH=16,NHEAD=16,SEQ=2048,D=64,DM=NHEAD*D;
constexpr int NW=8,QBLK=32,QB=QBLK*NW,KVBLK=64,NQB=SEQ/QB;
constexpr int ATTN_PITCH=DM, ATTN_UNIT_ROWS=QB;
__device__ __forceinline__ int crow(int r,int hi){return (r&3)+8*(r>>2)+4*hi;}
#define SBAR() __builtin_amdgcn_sched_barrier(0)
__device__ __forceinline__ void cmask(f32x16&p0,f32x16&p1,int jb,int qrel,int hi){
  const float NEG=-INFINITY; const int qd=qrel-64*jb-4*hi;
  #pragma unroll
  for(int r=0;r<16;++r){const int c=(r&3)+8*(r>>2); if(c>qd)p0[r]=NEG; if(c+32>qd)p1[r]=NEG;}
}

constexpr int NSLOT=3, SLOTB=8192;
constexpr int LDS_K=0, LDS_V=NSLOT*SLOTB, LDS_WS=2*NSLOT*SLOTB, LDS_OST=LDS_WS+NW*64*4, LDS_TAB=LDS_OST+NW*4096, LDS_BYTES=LDS_TAB+8192;
constexpr float C2=0.125f*1.4426950408889634f;
__device__ __forceinline__ void glds16(const void*gsrc,unsigned lds_dst){unsigned keep;
  asm volatile("s_mov_b32 %0, m0\n\ts_mov_b32 m0, %2\n\ts_nop 0\n\tglobal_load_lds_dwordx4 %1, off\n\ts_mov_b32 m0, %0":"=&s"(keep):"v"(gsrc),"s"(lds_dst):"memory");}
__device__ __forceinline__ float max3f(float a,float b,float c){float r;asm("v_max3_f32 %0, %1, %2, %3":"=v"(r):"v"(a),"v"(b),"v"(c));return r;}
__device__ __forceinline__ float max2f(float a,float b){float r;asm("v_max_f32_e32 %0, %1, %2":"=v"(r):"v"(a),"v"(b));return r;}
__device__ __forceinline__ float fadd_s(float a,float b){float r;asm("v_add_f32_e32 %0, %1, %2":"=v"(r):"v"(a),"v"(b));return r;}
__device__ __forceinline__ float fsub_s(float a,float b){float r;asm("v_sub_f32_e32 %0, %1, %2":"=v"(r):"v"(a),"v"(b));return r;}
typedef float f32x2_t __attribute__((ext_vector_type(2))); typedef float f32x4_t __attribute__((ext_vector_type(4))); typedef __bf16 bf16x2_t __attribute__((ext_vector_type(2)));
__device__ __forceinline__ unsigned cvtpk_s(float lo,float hi){f32x2_t v={lo,hi};bf16x2_t b=__builtin_convertvector(v,bf16x2_t);return __builtin_bit_cast(unsigned,b);}
#define WAIT_BAR(N) asm volatile("s_waitcnt vmcnt(" #N ") lgkmcnt(0)\n\ts_barrier":::"memory")

__device__ __forceinline__ void qkt(f32x16&p0,f32x16&p1,const char*Kslot,const bf16x8*qr,int r32,int hi){
  const char*kb=Kslot+hi*1024+r32*16;
  #pragma unroll
  for(int d0=0;d0<4;++d0){
    const bf16x8 b0=*reinterpret_cast<const bf16x8*>(kb+d0*2048);
    const bf16x8 b1=*reinterpret_cast<const bf16x8*>(kb+d0*2048+512);
    {p0=__builtin_amdgcn_mfma_f32_32x32x16_bf16(b0,qr[d0],p0,0,0,0);p1=__builtin_amdgcn_mfma_f32_32x32x16_bf16(b1,qr[d0],p1,0,0,0);}}
}
typedef __attribute__((address_space(3))) const char* lds_cptr;
typedef short v4i16_t __attribute__((ext_vector_type(4)));
__device__ __forceinline__ void kload8(bf16x8*kf,lds_cptr kp){
  kf[0]=*(const __attribute__((address_space(3))) bf16x8*)(kp);      kf[1]=*(const __attribute__((address_space(3))) bf16x8*)(kp+512);
  kf[2]=*(const __attribute__((address_space(3))) bf16x8*)(kp+2048); kf[3]=*(const __attribute__((address_space(3))) bf16x8*)(kp+2560);
  kf[4]=*(const __attribute__((address_space(3))) bf16x8*)(kp+4096); kf[5]=*(const __attribute__((address_space(3))) bf16x8*)(kp+4608);
  kf[6]=*(const __attribute__((address_space(3))) bf16x8*)(kp+6144); kf[7]=*(const __attribute__((address_space(3))) bf16x8*)(kp+6656);
}
__device__ __forceinline__ void kload2(bf16x8*kf,lds_cptr kp,int j){ kf[2*j]=*(const __attribute__((address_space(3))) bf16x8*)(kp+j*2048); kf[2*j+1]=*(const __attribute__((address_space(3))) bf16x8*)(kp+j*2048+512); }
__device__ __forceinline__ s16x4 vtr(lds_cptr p){ return __builtin_bit_cast(s16x4,__builtin_amdgcn_ds_read_tr16_b64_v4i16((__attribute__((address_space(3))) v4i16_t*)p)); }
__device__ __forceinline__ float rowmax(const f32x16&p0,const f32x16&p1){
  float a=max3f(p0[0],p0[1],p1[0]),b=max3f(p0[2],p0[3],p1[1]);a=max3f(a,p1[2],p1[3]);
  #pragma unroll
  for(int r=4;r<16;r+=4){a=max3f(a,p0[r],p0[r+1]);b=max3f(b,p0[r+2],p0[r+3]);a=max3f(a,p1[r],p1[r+1]);b=max3f(b,p1[r+2],p1[r+3]);}
  const float m=max2f(a,b);
  auto rr=__builtin_amdgcn_permlane32_swap(__float_as_uint(m),__float_as_uint(m),false,false);
  return max2f(__uint_as_float(rr[0]),__uint_as_float(rr[1]));
}
__device__ __forceinline__ void pv(f32x16*o,int vb,bf16x8 pa0,bf16x8 pa1,bf16x8 pa2,bf16x8 pa3){
  #pragma unroll
  for(int d0=0;d0<2;++d0){s16x4 lo[4],hi[4];
    #pragma unroll
    for(int ks=0;ks<4;++ks){
      asm volatile("ds_read_b64_tr_b16 %0,%1 offset:%c2":"=&v"(lo[ks]):"v"(vb),"i"(d0*4096+ks*1024):"memory");
      asm volatile("ds_read_b64_tr_b16 %0,%1 offset:%c2":"=&v"(hi[ks]):"v"(vb),"i"(d0*4096+ks*1024+512):"memory");}
    asm volatile("s_waitcnt lgkmcnt(0)":::"memory");SBAR();
    #define PK(k) (bf16x8){lo[k][0],lo[k][1],lo[k][2],lo[k][3],hi[k][0],hi[k][1],hi[k][2],hi[k][3]}
    o[d0]=__builtin_amdgcn_mfma_f32_32x32x16_bf16(pa0,PK(0),o[d0],0,0,0);
    o[d0]=__builtin_amdgcn_mfma_f32_32x32x16_bf16(pa1,PK(1),o[d0],0,0,0);
    o[d0]=__builtin_amdgcn_mfma_f32_32x32x16_bf16(pa2,PK(2),o[d0],0,0,0);
    o[d0]=__builtin_amdgcn_mfma_f32_32x32x16_bf16(pa3,PK(3),o[d0],0,0,0);
    #undef PK
  }
}

#ifndef ATTN_STORE16
#define ATTN_STORE16(p,v) (*(u32x4*)(p)=(v))
#endif
struct AttnExtra { const float* kbias; const float* kpart; const float* relb; };
template<int THRL,int MODE> __device__ __forceinline__ void attn_unit(int b,int h,int qb,const bf16*Q,const bf16*__restrict__ K,const bf16*__restrict__ V,bf16*O,char*shm,const AttnExtra&X,const int tid){
  const int lane=tid&63,r32=lane&31,hi=lane>>5; const int wid=__builtin_amdgcn_readfirstlane(tid>>6);
  const long rowbase=(long)b*SEQ; const int q0=qb*QB;
  const bf16*Qw=Q+(rowbase+q0+wid*QBLK)*DM+h*D;
  const bf16*Kh=K+rowbase*DM+h*D,*Vh=V+rowbase*DM+h*D;
  const unsigned lds0=(unsigned)(uintptr_t)shm;
  float*wsf=(float*)(shm+LDS_WS)+wid*64;
  const bf16*ksrc=Kh+(long)lane*DM+wid*8;
  const bf16*vsrc=Vh+(long)(16*(wid&3)+(lane>>2))*DM+(wid>>2)*32+(lane&3)*8;
  const unsigned kdst=lds0+LDS_K+wid*1024, vdst=lds0+LDS_V+wid*1024;
  #define DMA_K(t,slot) glds16(ksrc+(long)(t)*KVBLK*DM,(unsigned)__builtin_amdgcn_readfirstlane(kdst+(slot)))
  #define DMA_V(t,slot) glds16(vsrc+(long)(t)*KVBLK*DM,(unsigned)__builtin_amdgcn_readfirstlane(vdst+(slot)))
  const int vb0=(int)(lds0+LDS_V)+((lane>>4)&1)*32+(lane&3)*8+(4*hi+((lane&15)>>2))*64;
  const char*Kbase=shm+LDS_K; bf16x8 kf[8];
  const lds_cptr shm3=(lds_cptr)shm; const lds_cptr kp0=shm3+LDS_K+hi*1024+r32*16; const lds_cptr vp0=shm3+LDS_V+((lane>>4)&1)*32+(lane&3)*8+(4*hi+((lane&15)>>2))*64;
  const int NT=(q0+QB)/KVBLK;
  const lds_cptr tab3=(lds_cptr)shm+LDS_TAB;
  { int tq_=tid; asm volatile("":"+v"(tq_)); __attribute__((address_space(3))) float* tabw=(__attribute__((address_space(3))) float*)((__attribute__((address_space(3))) char*)shm+LDS_TAB);
    if(MODE==0){ const f32x4_t kv=*reinterpret_cast<const f32x4_t*>(X.kbias+tq_*4); *reinterpret_cast<__attribute__((address_space(3))) f32x4_t*>(tabw+tq_*4)=kv; }
    else{ const int hm=h-8; { const int j=tq_>>6,d=tq_&63; const float*kp=X.kpart+(long)((b*8+j)*2)*512+hm*64+d; tabw[j*64+d]=(kp[0]+kp[512])*(1.0f/256.0f); }
      { const int tv=tq_; const int n=tv-256; float val=0.f;
        if(n>=0&&n<113){ int bk=n; if(n>=16){ bk=16+(n>=19)+(n>=21)+(n>=24)+(n>=27)+(n>=31)+(n>=35)+(n>=40)+(n>=46)+(n>=52)+(n>=59)+(n>=67)+(n>=77)+(n>=87)+(n>=99); }
          val=(X.relb[bk*8+hm]-X.relb[31*8+hm])*1.4426950408889634f; }
        tabw[512+tv]=val; } } }
  DMA_K(0,0);DMA_V(0,0);DMA_K(1,SLOTB);
  bf16x8 qr[4];
  { int lq_=lane; asm volatile("":"+v"(lq_)); const int rq_=lq_&31,hq_=lq_>>5;
  #pragma unroll
  for(int d0=0;d0<4;++d0)qr[d0]=*reinterpret_cast<const bf16x8*>(&Qw[(long)rq_*DM+d0*16+hq_*8]); }
  float mhat=0.f,l_reg=0.f;f32x16 o[2];o[0]=f32x16{};o[1]=f32x16{};
  const int qrel=wid*QBLK+r32;
  unsigned selmask=0u;
  #define CINIT(C0,C1,t) do{ const int t_=(t); \
    if(MODE==0){ const lds_cptr kbp_=tab3+(64*t_+4*hi)*4; \
      _Pragma("unroll") for(int j_=0;j_<4;++j_){ const f32x4_t a_=*(const __attribute__((address_space(3))) f32x4_t*)(kbp_+32*j_); const f32x4_t b_=*(const __attribute__((address_space(3))) f32x4_t*)(kbp_+128+32*j_); \
        _Pragma("unroll") for(int i_=0;i_<4;++i_){ C0[4*j_+i_]=a_[i_]-mhat; C1[4*j_+i_]=b_[i_]-mhat; } } } \
    else{ const int blk_=t_>>2; const bool keep_=(blk_>=qb)||(((selmask>>blk_)&1u)!=0u); const float c_=keep_?-mhat:-INFINITY; \
      _Pragma("unroll") for(int r_=0;r_<16;++r_){C0[r_]=c_;C1[r_]=c_;} } }while(0)
  #define TMASK(P0,P1,t) do{ const int t_=(t); \
    if(MODE==1){ \
      if(64*t_+176>q0+32*wid){ const int db_=(q0-64*t_)+qrel-4*hi; \
        const lds_cptr tbp_=tab3+2048+4*(db_+256-63); \
        _Pragma("unroll") for(int r_=0;r_<16;++r_){ const int ko_=(r_&3)+8*(r_>>2); \
          P0[r_]+=*(const __attribute__((address_space(3))) float*)(tbp_+4*(63-ko_)); P1[r_]+=*(const __attribute__((address_space(3))) float*)(tbp_+4*(31-ko_)); } } } \
    { const int jb_=t_-(NT-4); if(jb_>=0)cmask(P0,P1,jb_,qrel,hi); } }while(0)
  #define CMASK(P0,P1,t) TMASK(P0,P1,t)
  bool resc=false;
  #define START(P0,P1) do{ const float rm=rowmax(P0,P1); resc=false; \
    { const float dl=(rm>-INFINITY)?rm:0.f; mhat=fadd_s(mhat,dl); \
      _Pragma("unroll") for(int r=0;r<16;++r){P0[r]=fsub_s(P0[r],dl);P1[r]=fsub_s(P1[r],dl);} \
    } \
    _Pragma("unroll") for(int r=0;r<16;++r)P0[r]=__builtin_amdgcn_exp2f(P0[r]); }while(0)
  #define RESC() do{ if(resc){ asm volatile("s_waitcnt lgkmcnt(0)":::"memory"); \
      _Pragma("unroll") for(int d_=0;d_<2;++d_) _Pragma("unroll") for(int r=0;r<16;++r)o[d_][r]*=wsf[crow(r,hi)]; } }while(0)
  f32x16 pA0,pA1,pB0,pB1;
  int sl_prev=0,sl_cur=0,sl_next=SLOTB;
  #define ROT() do{sl_prev=sl_cur;sl_cur=sl_next;sl_next=(sl_next==(NSLOT-1)*SLOTB)?0:sl_next+SLOTB;}while(0)
  DMA_K(2,2*SLOTB);
  WAIT_BAR(3);
  if(MODE==1){
    float gt[7];
    #pragma unroll
    for(int j=0;j<7;++j){ float s=0.f;
      #pragma unroll
      for(int d0=0;d0<4;++d0){ const f32x4_t ka=*(const __attribute__((address_space(3))) f32x4_t*)(tab3+(j*64+16*d0+8*hi)*4); const f32x4_t kb2=*(const __attribute__((address_space(3))) f32x4_t*)(tab3+(j*64+16*d0+8*hi+4)*4);
        #pragma unroll
        for(int i=0;i<4;++i){ s+=__uint_as_float(((unsigned)(unsigned short)qr[d0][i])<<16)*ka[i]; s+=__uint_as_float(((unsigned)(unsigned short)qr[d0][4+i])<<16)*kb2[i]; } }
      auto rr=__builtin_amdgcn_permlane32_swap(__float_as_uint(s),__float_as_uint(s),false,false); s=__uint_as_float(rr[0])+__uint_as_float(rr[1]);
      gt[j]=(j<qb)?s:-INFINITY; }
    #pragma unroll
    for(int j=0;j<7;++j){ int rk=0;
      #pragma unroll
      for(int k=0;k<7;++k){ if(k!=j){ rk+=(gt[k]>gt[j]||(gt[k]==gt[j]&&k<j))?1:0; } }
      if(j<qb&&rk<3)selmask|=(1u<<j); } }
  CINIT(pA0,pA1,0); qkt(pA0,pA1,Kbase,qr,r32,hi);asm volatile("s_nop 15\n\ts_nop 7":"+v"(pA0),"+v"(pA1));CMASK(pA0,pA1,0);
  START(pA0,pA1);
  _Pragma("unroll") for(int r=0;r<16;++r)pA1[r]=__builtin_amdgcn_exp2f(pA1[r]);
  WAIT_BAR(0);
  DMA_K(3,0);DMA_V(1,SLOTB);
  ROT();
  kload8(kf,kp0+sl_cur);
  WAIT_BAR(2);
  s16x4 vlo[8],vhi[8]; u32x4 pw0,pw1,pw2,pw3;
  #define PKW(P,B) cvtpk_s(P[B],P[B+1])
  #define PAF(k) __builtin_bit_cast(bf16x8,pw##k)
  #define VFR(i) (bf16x8){vlo[i][0],vlo[i][1],vlo[i][2],vlo[i][3],vhi[i][0],vhi[i][1],vhi[i][2],vhi[i][3]}
  #define PIN(x) asm volatile("":"+v"(x))
  #define MX3(a,b,c) __builtin_fmaxf(__builtin_fmaxf((a),(b)),(c))
  #define GAPA(MF,A0,A1,A2,A3,W0,W1,PW) do{ MF; sacc+=A0; sacc+=A1; sacc+=A2; sacc+=A3; PIN(sacc); W0; W1; PIN(PW); SBAR(); }while(0)
  #define EX(v) __builtin_amdgcn_exp2f(v)
  #define GAPB(MF,X,B) do{ MF; X[B]=EX(X[B]); X[B+1]=EX(X[B+1]); X[B+2]=EX(X[B+2]); X[B+3]=EX(X[B+3]); PIN(X); SBAR(); }while(0)
  #define VRD(i) do{ vlo[i]=vtr(vp_+(((i)>>2)*4096+((i)&3)*1024)); vhi[i]=vtr(vp_+(((i)>>2)*4096+((i)&3)*1024+512)); }while(0)
  #define KRD(G,j) do{ if(G){ kload2(kf,kp0+sl_next,j); SBAR(); } }while(0)
  #define STEP(C0,C1,P0,P1,t,GK,GV,GL) do{ SBAR(); CINIT(C0,C1,t); SBAR(); \
    const lds_cptr vp_=vp0+sl_prev; \
    VRD(0); SBAR(); float sacc=(P0[0]+P0[1]); \
    GAPA(C0=__builtin_amdgcn_mfma_f32_32x32x16_bf16(kf[0],qr[0],C0,0,0,0), P0[2],P0[3],P0[4],P0[5],     pw0[0]=PKW(P0,0), pw0[1]=PKW(P0,2), pw0); \
    VRD(4); SBAR(); GAPA(C1=__builtin_amdgcn_mfma_f32_32x32x16_bf16(kf[1],qr[0],C1,0,0,0), P0[6],P0[7],P0[8],P0[9],     pw0[2]=PKW(P0,4), pw0[3]=PKW(P0,6), pw0); \
    VRD(1); SBAR(); GAPA(C0=__builtin_amdgcn_mfma_f32_32x32x16_bf16(kf[2],qr[1],C0,0,0,0),   P0[10],P0[11],P0[12],P0[13], pw1[0]=PKW(P0,8), pw1[1]=PKW(P0,10), pw1); \
    VRD(5); SBAR(); GAPA(C1=__builtin_amdgcn_mfma_f32_32x32x16_bf16(kf[3],qr[1],C1,0,0,0),   P0[14],P0[15],P1[0],P1[1],   pw1[2]=PKW(P0,12),pw1[3]=PKW(P0,14), pw1); \
    VRD(2); SBAR(); GAPA(C0=__builtin_amdgcn_mfma_f32_32x32x16_bf16(kf[4],qr[2],C0,0,0,0),   P1[2],P1[3],P1[4],P1[5],     pw2[0]=PKW(P1,0), pw2[1]=PKW(P1,2), pw2); \
    VRD(6); SBAR(); GAPA(C1=__builtin_amdgcn_mfma_f32_32x32x16_bf16(kf[5],qr[2],C1,0,0,0),   P1[6],P1[7],P1[8],P1[9],     pw2[2]=PKW(P1,4), pw2[3]=PKW(P1,6), pw2); \
    VRD(3); SBAR(); GAPA(C0=__builtin_amdgcn_mfma_f32_32x32x16_bf16(kf[6],qr[3],C0,0,0,0),   P1[10],P1[11],P1[12],P1[13], pw3[0]=PKW(P1,8), pw3[1]=PKW(P1,10), pw3); \
    VRD(7); SBAR(); GAPA(C1=__builtin_amdgcn_mfma_f32_32x32x16_bf16(kf[7],qr[3],C1,0,0,0),   P1[14],P1[15],0.f,0.f,       pw3[2]=PKW(P1,12),pw3[3]=PKW(P1,14), pw3); \
    l_reg+=sacc; \
    if(GK){DMA_K((t)+3,sl_cur);} if(GV){DMA_V((t)+1,sl_next);} \
    CMASK(C0,C1,t); \
    { float a=MX3(C0[0],C0[1],C1[0]),b=MX3(C0[2],C0[3],C1[1]); a=MX3(a,C1[2],C1[3]); \
      _Pragma("unroll") for(int r=4;r<16;r+=4){a=MX3(a,C0[r],C0[r+1]);b=MX3(b,C0[r+2],C0[r+3]);a=MX3(a,C1[r],C1[r+1]);b=MX3(b,C1[r+2],C1[r+3]);} \
      float rm=__builtin_fmaxf(a,b); { auto rr=__builtin_amdgcn_permlane32_swap(__float_as_uint(rm),__float_as_uint(rm),false,false); rm=__builtin_fmaxf(__uint_as_float(rr[0]),__uint_as_float(rr[1])); } \
      resc=false; \
      if(__builtin_expect(__any(rm>(float)THRL),0)){ const float dl=__builtin_fmaxf(rm,0.f); mhat+=dl; \
        _Pragma("unroll") for(int r=0;r<16;++r){C0[r]-=dl;C1[r]-=dl;} \
        const float f=__builtin_amdgcn_exp2f(-dl); l_reg*=f; if(hi==0)wsf[r32]=f; resc=true; } } \
    SBAR(); \
    GAPB(o[0]=__builtin_amdgcn_mfma_f32_32x32x16_bf16(PAF(0),VFR(0),o[0],0,0,0), C0,0); \
    GAPB(o[1]=__builtin_amdgcn_mfma_f32_32x32x16_bf16(PAF(0),VFR(4),o[1],0,0,0), C0,4); \
    KRD(GL,0); GAPB(o[0]=__builtin_amdgcn_mfma_f32_32x32x16_bf16(PAF(1),VFR(1),o[0],0,0,0), C0,8); \
    KRD(GL,1); GAPB(o[1]=__builtin_amdgcn_mfma_f32_32x32x16_bf16(PAF(1),VFR(5),o[1],0,0,0), C0,12); \
    KRD(GL,2); GAPB(o[0]=__builtin_amdgcn_mfma_f32_32x32x16_bf16(PAF(2),VFR(2),o[0],0,0,0), C1,0); \
    KRD(GL,3); GAPB(o[1]=__builtin_amdgcn_mfma_f32_32x32x16_bf16(PAF(2),VFR(6),o[1],0,0,0), C1,4); \
    GAPB(o[0]=__builtin_amdgcn_mfma_f32_32x32x16_bf16(PAF(3),VFR(3),o[0],0,0,0), C1,8); \
    GAPB(o[1]=__builtin_amdgcn_mfma_f32_32x32x16_bf16(PAF(3),VFR(7),o[1],0,0,0), C1,12); \
    }while(0)
  int t=1;
  for(;t+5<NT;t+=2){
    STEP(pB0,pB1,pA0,pA1,t,true,true,true);     WAIT_BAR(2); RESC(); ROT();
    STEP(pA0,pA1,pB0,pB1,t+1,true,true,true);   WAIT_BAR(2); RESC(); ROT();
  }
  #define ENDW(tt) do{ if((tt)+3<NT){WAIT_BAR(2);} else if((tt)+2<NT){WAIT_BAR(1);} else {WAIT_BAR(0);} }while(0)
  for(;t+1<NT;t+=2){
    STEP(pB0,pB1,pA0,pA1,t,(t+3<NT),(t+1<NT),(t+1<NT));       ENDW(t);   RESC(); ROT();
    STEP(pA0,pA1,pB0,pB1,t+1,(t+4<NT),(t+2<NT),(t+2<NT));     ENDW(t+1); RESC(); ROT();
  }
  STEP(pB0,pB1,pA0,pA1,NT-1,false,false,false); RESC();
  { float sacc=pB0[0]+pB0[1]; _Pragma("unroll") for(int r=2;r<16;++r)sacc+=pB0[r]; _Pragma("unroll") for(int r=0;r<16;++r)sacc+=pB1[r]; l_reg+=sacc;
    pw0=(u32x4){PKW(pB0,0),PKW(pB0,2),PKW(pB0,4),PKW(pB0,6)};pw1=(u32x4){PKW(pB0,8),PKW(pB0,10),PKW(pB0,12),PKW(pB0,14)};pw2=(u32x4){PKW(pB1,0),PKW(pB1,2),PKW(pB1,4),PKW(pB1,6)};pw3=(u32x4){PKW(pB1,8),PKW(pB1,10),PKW(pB1,12),PKW(pB1,14)};
    SBAR(); pv(o,vb0+sl_cur,PAF(0),PAF(1),PAF(2),PAF(3)); }
  #undef PKW
  #undef PAF
  #undef VFR
  #undef PIN
  #undef MX3
  #undef GAPA
  #undef GAPB
  #undef EX
  #undef VRD
  #undef KRD
  #undef STEP
  #undef ENDW
  {auto rr=__builtin_amdgcn_permlane32_swap(__float_as_uint(l_reg),__float_as_uint(l_reg),false,false);l_reg=__uint_as_float(rr[0])+__uint_as_float(rr[1]);}
  if(hi==0)wsf[32+r32]=l_reg;asm volatile("s_waitcnt lgkmcnt(0)":::"memory");
  float rli[16];
  #pragma unroll
  for(int r=0;r<16;++r)rli[r]=__builtin_amdgcn_rcpf(wsf[32+crow(r,hi)]);
  bf16*Ow=O+(rowbase+q0+wid*QBLK)*DM+h*D;
  { bf16*stg=(bf16*)(shm+LDS_OST)+wid*2048;
    #pragma unroll
    for(int r=0;r<16;++r){const int orow=crow(r,hi);
      #pragma unroll
      for(int d0=0;d0<2;++d0)stg[orow*64+d0*32+r32]=__float2bfloat16(o[d0][r]*rli[r]);}
    asm volatile("s_waitcnt lgkmcnt(0)":::"memory");
    int lv_=lane; asm volatile("":"+v"(lv_));
    #pragma unroll
    for(int i=0;i<4;++i){const int row=i*8+(lv_>>3),ch=lv_&7; const u32x4 v=*(const u32x4*)(stg+row*64+ch*8); ATTN_STORE16(Ow+(long)row*DM+ch*8,v);} }
  asm volatile("s_waitcnt lgkmcnt(0)\n\ts_barrier":::"memory");
  #undef DMA_K
  #undef DMA_V
  #undef CMASK
  #undef TMASK
  #undef CINIT
  #undef START
  #undef RESC
  #undef ROT
}
constexpr int ATTN_LDS_BYTES=LDS_BYTES;
struct AttnTensors { const bf16* Q; const bf16* K; const bf16* V; bf16* O; };
struct AttnUnit { int b, h, qb; };
struct StaticOrder {
  int vcu, G;
  __device__ __forceinline__ explicit StaticOrder(int grid,int vcu_):vcu(vcu_),G(grid){}
  __device__ __forceinline__ bool next(int i,AttnUnit&u)const{ const int L=i*G+vcu; if(L>=2048)return false; const int v=L&255,k=L>>8,s=v>>1; const int moba=(k>>2)&1; const int setA=((v&1)^moba);
    const int kk=k&3; const int qa=(kk==0)?0:(kk==1)?3:(kk==2)?4:7, qb2=(kk==0)?1:(kk==1)?2:(kk==2)?5:6;
    u.b=s>>3; u.h=(s&7)+8*moba; u.qb=setA?qb2:qa; return true; }
};
template<class Sched,int THRL=8> __device__ __forceinline__ void attn_phase(int tid,char*lds,const AttnTensors&T,const Sched&S,const float*kbias,const float*kpart,const float*relb){
  AttnUnit u;
  for(int i=0;S.next(i,u);++i){ AttnExtra X; X.kbias=kbias+(long)(u.b*8+(u.h&7))*SEQ; X.kpart=kpart; X.relb=relb;
#if !defined(ATT_ONLY) || ATT_ONLY==0
    if(u.h<8) attn_unit<THRL,0>(u.b,u.h,u.qb,T.Q,T.K,T.V,T.O,lds,X,tid);
#endif
#if !defined(ATT_ONLY) || ATT_ONLY==1
    if(u.h>=8) attn_unit<THRL,1>(u.b,u.h,u.qb,T.Q,T.K,T.V,T.O,lds,X,tid);
#endif
  }
}
#undef SBAR
#undef WAIT_BAR
}
#define XB_TMO      128
#define XB_XCNT(j)  (256  + 64 * (j))
#define XB_XSUB(j)  (1280 + 64 * (j))
#define XB_XGEN(j)  (2304 + 64 * (j))
#define XB_TOP      3328
#define XB_TOPGEN   3392
#define XCD_BAR_WORDS 3456
#define XB_SPIN_CAP (1u << 18)

__device__ __forceinline__ unsigned xb_ld(unsigned* p)              { return __hip_atomic_load(p, __ATOMIC_RELAXED, __HIP_MEMORY_SCOPE_AGENT); }
__device__ __forceinline__ unsigned xb_add(unsigned* p, unsigned v) { return __hip_atomic_fetch_add(p, v, __ATOMIC_RELAXED, __HIP_MEMORY_SCOPE_AGENT); }
__device__ __forceinline__ unsigned xb_xcc_id() { return (unsigned)__builtin_amdgcn_s_getreg((3 << 11) | 20) & 0xFu; }
#define XB_SPIN(cond, bar) do { unsigned _sp = 0; while (cond) { __builtin_amdgcn_s_sleep(1); \
    if ((++_sp & 255u) == 0u) { if (xb_ld(&(bar)[XB_TMO])) break; if (_sp > XB_SPIN_CAP) { atomicAdd(&(bar)[XB_TMO], 1u); break; } } } } while (0)

struct XcdBarrier {
    unsigned* bar; unsigned x;
    volatile LAS unsigned* st;
};

__device__ __forceinline__ XcdBarrier xcd_barrier_post(unsigned* bar, volatile LAS unsigned* st) {
    XcdBarrier b; b.bar = bar; b.x = xb_xcc_id(); b.st = st;
    if (threadIdx.x == 0) (void)xb_add(&bar[XB_XCNT(b.x)], 1u);
    return b;
}
__device__ __forceinline__ void xcd_barrier_complete(unsigned* bar, unsigned x, unsigned& nloc, unsigned& nx) {
    const unsigned G = gridDim.x * gridDim.y * gridDim.z;
    unsigned sum, cnt, mine, sp = 0u;
    for (;;) {
        sum = 0u; cnt = 0u; mine = 0u;
#pragma unroll
        for (unsigned j = 0; j < 16; ++j) { const unsigned c = xb_ld(&bar[XB_XCNT(j)]); sum += c; cnt += (c > 0u) ? 1u : 0u; mine = (j == x) ? c : mine; }
        if (sum == G) break;
        __builtin_amdgcn_s_sleep(1);
        if ((++sp & 255u) == 0u) { if (xb_ld(&bar[XB_TMO])) break; if (sp > XB_SPIN_CAP) { atomicAdd(&bar[XB_TMO], 1u); break; } }
    }
    nloc = mine > 0u ? mine : 1u; nx = cnt > 0u ? cnt : 1u;
}

__device__ __forceinline__ void xcd_barrier(const XcdBarrier& b) {
    asm volatile("s_waitcnt vmcnt(0)" ::: "memory");
    __syncthreads();
    if (threadIdx.x == 0) {
        unsigned* bar = b.bar;
        __builtin_amdgcn_s_waitcnt(0);
        unsigned nloc = b.st[0], nx = b.st[1];
        if (nloc == 0u) { xcd_barrier_complete(bar, b.x, nloc, nx); b.st[0] = nloc; b.st[1] = nx; }
        const unsigned old = xb_add(&bar[XB_XSUB(b.x)], 1u);
        const unsigned gen = old / nloc;
        if (old + 1u == (gen + 1u) * nloc) {
            __builtin_amdgcn_fence(__ATOMIC_RELEASE, "agent");
            asm volatile("s_waitcnt vmcnt(0)" ::: "memory");
            const unsigned og = xb_add(&bar[XB_TOP], 1u);
            const unsigned tg = og / nx;
            if (og + 1u == (tg + 1u) * nx) xb_add(&bar[XB_TOPGEN], 1u);
            else XB_SPIN(xb_ld(&bar[XB_TOPGEN]) == tg, bar);
            __builtin_amdgcn_fence(__ATOMIC_ACQUIRE, "agent");
            xb_add(&bar[XB_XGEN(b.x)], 1u);
            asm volatile("s_waitcnt vmcnt(0)" ::: "memory");
        } else {
            XB_SPIN(xb_ld(&bar[XB_XGEN(b.x)]) == gen, bar);
            __builtin_amdgcn_fence(__ATOMIC_ACQUIRE, "agent");
            asm volatile("s_waitcnt vmcnt(0)" ::: "memory");
        }
    }
    __syncthreads();
}
constexpr int NWAVES = 8;
#define LDS_WAIT() asm volatile("s_waitcnt lgkmcnt(0)" ::: "memory")
#define VM_WAIT() asm volatile("s_waitcnt vmcnt(0)" ::: "memory")
__device__ __forceinline__ float wave_sum(float v) {
#pragma unroll
    for (int o = 1; o < 64; o <<= 1) v += __shfl_xor(v, o);
    return v;
}
__device__ __forceinline__ void row_load(const float* p, int lane, f32x4 (&v)[4]) {
    const GAS f32x4* xr = (const GAS f32x4*)p + lane;
#pragma unroll
    for (int j = 0; j < 4; ++j) v[j] = xr[64 * j];
}
__device__ __forceinline__ void row_store_f32(float* p, int lane, const f32x4 (&v)[4]) {
    GAS f32x4* o = (GAS f32x4*)p + lane;
#pragma unroll
    for (int j = 0; j < 4; ++j) o[64 * j] = v[j];
}
__device__ __forceinline__ void row_store_bf16(bf16_t* p, int lane, const f32x4 (&v)[4]) {
    GAS u32x2* o = (GAS u32x2*)p + lane;
#pragma unroll
    for (int j = 0; j < 4; ++j) { u32x2 w; w.x = cvt_pk_bf16(v[j][0], v[j][1]); w.y = cvt_pk_bf16(v[j][2], v[j][3]); o[64 * j] = w; }
}
__device__ __forceinline__ void row_layernorm(f32x4 (&v)[4], const f32x4 (&g)[4], const f32x4 (&b)[4]) {
    float s = 0.f;
#pragma unroll
    for (int j = 0; j < 4; ++j) s += (v[j][0] + v[j][1]) + (v[j][2] + v[j][3]);
    const float mean = wave_sum(s) * (1.f / DM); float s2 = 0.f;
#pragma unroll
    for (int j = 0; j < 4; ++j) { v[j] = v[j] - mean; s2 += (v[j][0] * v[j][0] + v[j][1] * v[j][1]) + (v[j][2] * v[j][2] + v[j][3] * v[j][3]); }
    const float rstd = 1.f / sqrtf(wave_sum(s2) * (1.f / DM) + LN_EPS);
#pragma unroll
    for (int j = 0; j < 4; ++j) v[j] = v[j] * rstd * g[j] + b[j];
}
template <int H, int MASK, int N> __device__ __forceinline__ void bfly_step(float (&v)[N], int lane) {
    const bool up = (lane & MASK) != 0;
#pragma unroll
    for (int i = 0; i < H; ++i) { const float a = v[i], b = v[i + H]; const float send = up ? a : b, keep = up ? b : a; v[i] = keep + __shfl_xor(send, MASK); }
}
__device__ __forceinline__ void butterfly64(float (&v)[64], int lane) { bfly_step<32, 32>(v, lane); bfly_step<16, 16>(v, lane); bfly_step<8, 8>(v, lane); bfly_step<4, 4>(v, lane); bfly_step<2, 2>(v, lane); bfly_step<1, 1>(v, lane); }
__device__ __forceinline__ void butterfly32(float (&v)[32], int lane) { bfly_step<16, 32>(v, lane); bfly_step<8, 16>(v, lane); bfly_step<4, 8>(v, lane); bfly_step<2, 4>(v, lane); bfly_step<1, 2>(v, lane); v[0] += __shfl_xor(v[0], 1); }
template <int E> __device__ __forceinline__ void thin_dot(const f32x4 (&xn)[4][4], const LAS float* w, int ws, int lane, float (&acc)[4 * E]) {
#pragma unroll
    for (int i = 0; i < 4 * E; ++i) acc[i] = 0.f;
#pragma unroll
    for (int e = 0; e < E; ++e)
#pragma unroll
        for (int j = 0; j < 4; ++j) { const f32x4 wv = *(const LAS f32x4*)(w + e * ws + 4 * lane + 256 * j);
#pragma unroll
            for (int r = 0; r < 4; ++r) { float a = acc[r * E + e]; a = fmaf(xn[r][j][0], wv[0], a); a = fmaf(xn[r][j][1], wv[1], a); a = fmaf(xn[r][j][2], wv[2], a); a = fmaf(xn[r][j][3], wv[3], a); acc[r * E + e] = a; } }
}
__device__ __forceinline__ float log_sigmoid(float z) { const float a = fabsf(z); return fminf(z, 0.f) - log1pf(__expf(-a)); }

__device__ __forceinline__ void forget_rows(const f32x4 (&xn)[4][4], const LAS float* wf, const float* bf, float* logf, int t0, int lane) {
    float acc[32]; thin_dot<8>(xn, wf, 1024, lane, acc); butterfly32(acc, lane);
    const int r = lane >> 4, h = (lane >> 1) & 7, t = t0 + r;
    if ((lane & 1) == 0) logf[(size_t)((t >> 11) * 8 + h) * SEQ + (t & (SEQ - 1))] = log_sigmoid(acc[0] + bf[h]);
}
__device__ __forceinline__ void load_wf(const float* w_in_l, LAS float* wf, int tid) {
    for (int idx = tid; idx < 8192; idx += NWAVES * 64) { const int k = idx >> 3, h = idx & 7; wf[h * 1024 + k] = w_in_l[(size_t)k * IN_COLS + FCOL + h]; }
}

template <int MAPK> __device__ __forceinline__ int wt_map(int n) {
    if (MAPK == 0) return n;
    if (MAPK == 1) return n < FCOL ? n : (n < FCOL + 8 ? -1 : n - 8);
    return ((n & 1023) >> 7) * 256 + (n >> 10) * 128 + (n & 127);
}
template <int MAPK> __device__ __forceinline__ void transpose_item(const float* W, int K, int N, bf16_t* WT, LAS float* scr, int item, int lane) {
    const int nblk = (N + 31) / 32, kb = item / nblk, nb = item % nblk, k0 = 64 * kb, n0 = 32 * nb;
    const int nn = n0 + (lane & 31);
#pragma unroll 8
    for (int i = 0; i < 32; ++i) { const int kk = 2 * i + (lane >> 5); scr[kk * 33 + (lane & 31)] = (nn < N) ? W[(size_t)(k0 + kk) * N + nn] : 0.f; }
    LDS_WAIT(); asm volatile("" ::: "memory");
    const int c = lane & 7;
#pragma unroll
    for (int j = 0; j < 4; ++j) { const int nl = (lane >> 3) + 8 * j, n = n0 + nl; const int dr = wt_map<MAPK>(n); const LAS float* s = scr + (8 * c) * 33 + nl;
        u32x4 o; o.x = cvt_pk_bf16(s[0 * 33], s[1 * 33]); o.y = cvt_pk_bf16(s[2 * 33], s[3 * 33]); o.z = cvt_pk_bf16(s[4 * 33], s[5 * 33]); o.w = cvt_pk_bf16(s[6 * 33], s[7 * 33]);
        if (n < N && dr >= 0) *(GAS u32x4*)(WT + (size_t)dr * K + k0 + 8 * c) = o; }
    LDS_WAIT(); asm volatile("" ::: "memory");
}
constexpr size_t MiB = 1u << 20;
constexpr size_t WS_CTL = 0, CTL_ZERO_BYTES = 1 * MiB;
constexpr size_t WS_WIN = 2 * MiB, WS_WO = 26 * MiB, WS_WCQ = 34 * MiB, WS_WCK = 42 * MiB, WS_WCV = 50 * MiB, WS_WCO = 58 * MiB;
constexpr size_t WS_WGU = 66 * MiB, WS_WD = 578 * MiB;
constexpr size_t WS_XB = 834 * MiB, WS_Q = 898 * MiB, WS_K = 962 * MiB, WS_V = 1026 * MiB;
constexpr size_t WS_MEMB = 1090 * MiB, WS_KC = 1098 * MiB, WS_VT = 1130 * MiB;
constexpr size_t WS_LOGF = 1162 * MiB, WS_KB = 1163 * MiB, WS_KPART = 1164 * MiB;
constexpr size_t WS_ASGE = 1165 * MiB, WS_ASGR = WS_ASGE + 512 * 1024, WS_ASGG = 1166 * MiB;
constexpr size_t WS_STOK = 1167 * MiB;
constexpr size_t WS_ACT = 1171 * MiB, WS_YEXP = 1443 * MiB, WS_END = 1715 * MiB;
static_assert(WS_ACT + (size_t)MAXTILES * 256 * DM * 2 <= WS_YEXP && WS_YEXP + (size_t)MAXTILES * 256 * DM * 2 <= WS_END, "d_ws map");
constexpr int CW_TMO = 0, CW_CODE = 1;
constexpr int CW_BAR = 4096;
constexpr int CW_CNT = 16384;
static_assert((CW_CNT + NL * NE * 64) * 4 <= (int)CTL_ZERO_BYTES && CW_BAR + XCD_BAR_WORDS <= CW_CNT, "CTL words inside the memset region");
constexpr int RING_OFF = 0, RING_BYTES = 131072;
constexpr int XCH_OFF = RING_BYTES;
constexpr int MOE_OFF = XCH_OFF + 8192;
constexpr int ARGT_OFF = MOE_OFF + 288;
constexpr int MISC_OFF = MOE_OFF + 512;
constexpr int LDS_BYTES = 147456;
static_assert(MISC_OFF + 128 <= LDS_BYTES, "LDS map");
constexpr int NPHASE = 2 + 12 * NL;

struct Args { const float* in[22]; float* out; unsigned char* ws; int ph_lo, ph_hi; };

struct KVOrder {
    int G, c;
    __device__ __forceinline__ bool next(int i, pg8::Unit& u) const {
        const long L = (long)i * G + c; if (L >= 512) return false;
        const int wgid = pg8::xcd_chunk((int)L, 512), l = wgid >> 7, r = wgid & 127, kind = r >> 6, rr = r & 63;
        const int pm = kind ? (rr & 3) : (rr & 15), pn = kind ? (rr >> 2) : (rr >> 4);
        u.abyte = (long)(kind ? WS_WCV + (size_t)l * 2 * MiB : WS_MEMB) + (long)pm * 256 * DM * 2;
        u.bbyte = (long)(kind ? WS_MEMB : WS_WCK + (size_t)l * 2 * MiB) + (long)pn * 256 * DM * 2;
        u.orow = pm * 256; u.ocol = pn * 256; u.aux = l * 2 + kind; u.grow = 0; u.gcnt = 256; return true;
    }
};
struct EpiKV {
    static constexpr bool PERM = true;
    bf16_t* KC; bf16_t* VT;
    __device__ __forceinline__ void operator()(const f32x4 (&acc)[2][2][4][2], const pg8::Unit& u, const pg8::EpiCtx& c) const {
        const int l = u.aux >> 1, kind = u.aux & 1, ldc = kind ? TM : DM;
        bf16_t* O = (kind ? VT : KC) + (size_t)l * TM * DM;
        const int row0 = u.orow + c.wr * 64 + c.fr, col0 = u.ocol + c.wc * 32 + 8 * c.fq;
#pragma unroll
        for (int ai = 0; ai < 2; ++ai)
#pragma unroll
            for (int m = 0; m < 4; ++m) { bf16_t* rowp = O + (size_t)(row0 + ai * 128 + m * 16) * ldc + col0;
#pragma unroll
                for (int bj = 0; bj < 2; ++bj) { const f32x4 v0 = acc[ai][bj][m][0], v1 = acc[ai][bj][m][1];
                    u32x4 w; w.x = cvt_pk_bf16(v0[0], v0[1]); w.y = cvt_pk_bf16(v0[2], v0[3]); w.z = cvt_pk_bf16(v1[0], v1[1]); w.w = cvt_pk_bf16(v1[2], v1[3]);
                    *(u32x4*)(rowp + bj * 128) = w; } }
    }
};

#define PHASE_TID() int lane_; asm volatile("v_mbcnt_lo_u32_b32 %0, -1, 0\n\tv_mbcnt_hi_u32_b32 %0, -1, %0" : "=v"(lane_)); const int lane = lane_; const int wave = wave0; const int ptid = wave * 64 + lane; (void)lane; (void)wave; (void)ptid
__device__ __forceinline__ const float* argp(const LAS unsigned long long* tab, int i) {
    const unsigned long long v = tab[i]; const unsigned lo = __builtin_amdgcn_readfirstlane((unsigned)v), hi = __builtin_amdgcn_readfirstlane((unsigned)(v >> 32));
    return (const float*)(((unsigned long long)hi << 32) | lo);
}
__global__ void __launch_bounds__(NWAVES * 64, 2) skel_fwd(Args args) {
    extern __shared__ __attribute__((aligned(16))) unsigned char lds_raw[];
    LAS unsigned char* lds = (LAS unsigned char*)lds_raw;
    volatile LAS unsigned* MISC = (volatile LAS unsigned*)(lds + MISC_OFF);
    const int G = gridDim.x; const int bx = blockIdx.x; const int vcu = (G % 8 == 0) ? (bx % 8) * (G / 8) + bx / 8 : bx;
    const int lo = args.ph_lo, hi = args.ph_hi;
    const int wave0 = __builtin_amdgcn_readfirstlane((int)threadIdx.x >> 6);
    LAS unsigned long long* ARGT = (LAS unsigned long long*)(lds + ARGT_OFF);
    { const int tid0 = threadIdx.x;
      for (int u = tid0; u < (LDS_BYTES - XCH_OFF) / 4; u += NWAVES * 64) ((LAS unsigned*)(lds + XCH_OFF))[u] = 0u;
      __syncthreads();
      if (tid0 == 0) {
#pragma unroll
          for (int i = 0; i < 22; ++i) ARGT[i] = (unsigned long long)args.in[i];
          ARGT[22] = (unsigned long long)args.out; ARGT[23] = (unsigned long long)args.ws; }
      __syncthreads(); }
    if (hi - lo > 1) { const XcdBarrier b0 = xcd_barrier_post((unsigned*)(args.ws + WS_CTL) + CW_BAR, MISC + 8); if (threadIdx.x == 0) MISC[10] = b0.x; }
    __syncthreads();
#ifndef PHASE_MASK
#define PHASE_MASK 0xFFFF
#endif
#define PH_ON(kind) (((PHASE_MASK) >> (kind)) & 1)
#define IN(k) (lo <= (k) && (k) < hi)
#define BOTH(k) (IN(k) && IN((k) + 1))
#define SEAM(k) do { if (BOTH(k)) { XcdBarrier b_; b_.bar = (unsigned*)WSP() + CW_BAR; b_.x = (unsigned)__builtin_amdgcn_readfirstlane((int)MISC[10]); b_.st = MISC + 8; xcd_barrier(b_); } } while (0)
#define ARGF(i) argp(ARGT, (i))
#define WSP() ((unsigned char*)ARGF(23))
    LAS int* TP = (LAS int*)(lds + MOE_OFF); LAS int* CNT = TP + 40;
    LAS unsigned char* xch = lds + XCH_OFF;
    const int NGW = G * NWAVES;

    if (PH_ON(0) && IN(0)) {
        PHASE_TID(); unsigned char* ws = WSP(); const int gw = vcu * NWAVES + wave;
        const float* x_in = ARGF(0); const float* mem = ARGF(1); const float* w_in = ARGF(2); const float* b_forget = ARGF(3); const float* w_mix_out = ARGF(4);
        const float* w_cq = ARGF(8); const float* w_ck = ARGF(9); const float* w_cv = ARGF(10); const float* w_co = ARGF(11); const float* w_gate_up = ARGF(16); const float* w_down = ARGF(18);
        LAS float* scr = (LAS float*)(lds + RING_OFF + wave * 16384);
        constexpr int I_IN = 16 * 97, I_SQ = 16 * 32, I_GU = 16 * 64, PER_L = I_IN + 5 * I_SQ + NE * I_GU + NE * I_SQ;
        for (int it = gw; it < NL * PER_L; it += NGW) {
            const int l = it / PER_L; int r = it % PER_L;
            if (r < I_IN) { transpose_item<1>(w_in + (size_t)l * DM * IN_COLS, DM, IN_COLS, (bf16_t*)(ws + WS_WIN) + (size_t)l * IN_N * DM, scr, r, lane); continue; } r -= I_IN;
            if (r < 5 * I_SQ) { const int which = r / I_SQ, item = r % I_SQ;
                const float* W = (which == 0 ? w_mix_out : which == 1 ? w_cq : which == 2 ? w_ck : which == 3 ? w_cv : w_co) + (size_t)l * DM * DM;
                bf16_t* WT = (bf16_t*)(ws + (which == 0 ? WS_WO : which == 1 ? WS_WCQ : which == 2 ? WS_WCK : which == 3 ? WS_WCV : WS_WCO)) + (size_t)l * DM * DM;
                transpose_item<0>(W, DM, DM, WT, scr, item, lane); continue; } r -= 5 * I_SQ;
            if (r < NE * I_GU) { const int e = r / I_GU, item = r % I_GU;
                transpose_item<2>(w_gate_up + (size_t)(l * NE + e) * DM * 2048, DM, 2048, (bf16_t*)(ws + WS_WGU) + (size_t)(l * NE + e) * 2048 * DM, scr, item, lane); continue; } r -= NE * I_GU;
            { const int e = r / I_SQ, item = r % I_SQ;
                transpose_item<0>(w_down + (size_t)(l * NE + e) * DM * DM, DM, DM, (bf16_t*)(ws + WS_WD) + (size_t)(l * NE + e) * DM * DM, scr, item, lane); }
        }
        __syncthreads();
        LAS float* wf = (LAS float*)(lds + RING_OFF);
        load_wf(w_in, wf, ptid);
        __syncthreads();
        bf16_t* XB = (bf16_t*)(ws + WS_XB); float* LOGF = (float*)(ws + WS_LOGF); bf16_t* MEMB = (bf16_t*)(ws + WS_MEMB);
        for (int rg = gw; rg < T / 16; rg += NGW)
            for (int g4 = 0; g4 < 4; ++g4) { const int t0 = rg * 16 + g4 * 4; f32x4 xn[4][4];
#pragma unroll
                for (int r = 0; r < 4; ++r) { row_load(x_in + (size_t)(t0 + r) * DM, lane, xn[r]); row_store_bf16(XB + (size_t)(t0 + r) * DM, lane, xn[r]); }
                forget_rows(xn, wf, b_forget, LOGF, t0, lane); }
        for (int m = gw; m < TM; m += NGW) { f32x4 v[4]; row_load(mem + (size_t)m * DM, lane, v); row_store_bf16(MEMB + (size_t)m * DM, lane, v); }
        __syncthreads();
        SEAM(0);
    }
    if (PH_ON(1) && IN(1)) {
        PHASE_TID(); unsigned char* ws = WSP();
        pg8::Gemm g{(const bf16_t*)ws, (const bf16_t*)ws, DM, DM, DM, nullptr}; KVOrder S{G, bx}; EpiKV E{(bf16_t*)(ws + WS_KC), (bf16_t*)(ws + WS_VT)};
        pg8::gemm_phase<EpiKV, KVOrder, false, true>(ptid, lds + RING_OFF, xch, g, S, E);
        SEAM(1);
    }
    for (int l = 0; l < NL; ++l) {
        const int pb = 2 + 12 * l;
        if (PH_ON(2) && IN(pb + 0)) {
            PHASE_TID(); unsigned char* ws = WSP();
            { float* LOGF = (float*)(ws + WS_LOGF); float* KBIAS = (float*)(ws + WS_KB);
              for (int sq = bx; sq < NB * 8; sq += G) {
                const f32x4 v = *(const f32x4*)(LOGF + (size_t)sq * SEQ + ptid * 4);
                const float p0 = v[0], p1 = p0 + v[1], p2 = p1 + v[2], p3 = p2 + v[3];
                float inc = p3;
#pragma unroll
                for (int o = 1; o < 64; o <<= 1) { const float n = __shfl_up(inc, o); if (lane >= o) inc += n; }
                LAS float* wt = (LAS float*)xch;
                if (lane == 63) wt[wave] = inc;
                __syncthreads();
                float off = inc - p3;
                for (int w = 0; w < wave; ++w) off += wt[w];
                f32x4 o; o[0] = -(off + p0) * LOG2E; o[1] = -(off + p1) * LOG2E; o[2] = -(off + p2) * LOG2E; o[3] = -(off + p3) * LOG2E;
                *(f32x4*)(KBIAS + (size_t)sq * SEQ + ptid * 4) = o;
                __syncthreads();
              } }
            pg8::Gemm g{(const bf16_t*)(ws + WS_XB), (const bf16_t*)(ws + WS_WIN) + (size_t)l * IN_N * DM, DM, DM, DM, nullptr};
            pg8::GridOrder<0> S; S.init(T / 256, IN_N / 256, G, bx, DM, DM);
            pg8::EpiQKV E{(bf16_t*)(ws + WS_Q), (bf16_t*)(ws + WS_K), (bf16_t*)(ws + WS_V), (float*)(ws + WS_KPART)};
            pg8::gemm_phase<pg8::EpiQKV, pg8::GridOrder<0>, false, true>(ptid, lds + RING_OFF, xch, g, S, E);
            SEAM(pb + 0);
        }
        if (PH_ON(3) && IN(pb + 1)) {
            PHASE_TID(); unsigned char* ws = WSP();
            const attn_body::AttnTensors AT{(const attn_body::bf16*)(ws + WS_Q), (const attn_body::bf16*)(ws + WS_K), (const attn_body::bf16*)(ws + WS_V), (attn_body::bf16*)(ws + WS_Q)};
            const attn_body::StaticOrder S(G, vcu);
            attn_body::attn_phase<attn_body::StaticOrder>(ptid, (char*)lds_raw + RING_OFF, AT, S, (const float*)(ws + WS_KB), (const float*)(ws + WS_KPART), ARGF(5));
            SEAM(pb + 1);
        }
        if (PH_ON(4) && IN(pb + 2)) {
            PHASE_TID(); unsigned char* ws = WSP(); float* X = (float*)ARGF(22);
            pg8::Gemm g{(const bf16_t*)(ws + WS_Q), (const bf16_t*)(ws + WS_WO) + (size_t)l * DM * DM, DM, DM, DM, nullptr};
            pg8::GridOrder<0> S; S.init(T / 256, DM / 256, G, bx, DM, DM);
            pg8::EpiResid E{l == 0 ? ARGF(0) : (const float*)X, X};
            pg8::gemm_phase<pg8::EpiResid, pg8::GridOrder<0>, false, true>(ptid, lds + RING_OFF, xch, g, S, E);
            SEAM(pb + 2);
        }
        if (PH_ON(5) && IN(pb + 3)) {
            PHASE_TID(); unsigned char* ws = WSP(); float* X = (float*)ARGF(22); bf16_t* XB = (bf16_t*)(ws + WS_XB); const int gw = vcu * NWAVES + wave;
            f32x4 gg[4], bb[4]; row_load(ARGF(6) + (size_t)l * DM, lane, gg); row_load(ARGF(7) + (size_t)l * DM, lane, bb);
            for (int rg = gw; rg < T / 16; rg += NGW)
                for (int r = 0; r < 16; ++r) { const size_t t = (size_t)rg * 16 + r; f32x4 v[4]; row_load(X + t * DM, lane, v); row_layernorm(v, gg, bb);
                    row_store_f32(X + t * DM, lane, v); row_store_bf16(XB + t * DM, lane, v); }
            SEAM(pb + 3);
        }
        if (PH_ON(6) && IN(pb + 4)) {
            PHASE_TID(); unsigned char* ws = WSP();
            pg8::Gemm g{(const bf16_t*)(ws + WS_XB), (const bf16_t*)(ws + WS_WCQ) + (size_t)l * DM * DM, DM, DM, DM, nullptr};
            pg8::GridOrder<0> S; S.init(T / 256, DM / 256, G, bx, DM, DM);
            pg8::EpiBf16S E{(bf16_t*)(ws + WS_Q), DM, C2_CROSS, nullptr, 0, 1};
            pg8::gemm_phase<pg8::EpiBf16S, pg8::GridOrder<0>, false, true>(ptid, lds + RING_OFF, xch, g, S, E);
            SEAM(pb + 4);
        }
        if (PH_ON(7) && IN(pb + 5)) {
            PHASE_TID(); unsigned char* ws = WSP();
            pg8::Gemm g{(const bf16_t*)(ws + WS_Q), (const bf16_t*)(ws + WS_KC) + (size_t)l * TM * DM, DM, DM, 256, nullptr};
            pg8::GridOrder<1> S; S.init(T / 256, 4, G, bx, DM, DM);
            pg8::EpiSoftmax E{(bf16_t*)(ws + WS_K)};
            pg8::gemm_phase<pg8::EpiSoftmax, pg8::GridOrder<1>, false, true>(ptid, lds + RING_OFF, xch, g, S, E);
            SEAM(pb + 5);
        }
        if (PH_ON(8) && IN(pb + 6)) {
            PHASE_TID(); unsigned char* ws = WSP();
            pg8::Gemm g{(const bf16_t*)(ws + WS_K), (const bf16_t*)(ws + WS_VT) + (size_t)l * TM * DM, DM, TM, 256, nullptr};
            pg8::GridOrder<2> S; S.init(T / 256, 4, G, bx, DM, TM);
            pg8::EpiBf16S E{(bf16_t*)(ws + WS_V), DM, 1.0f, nullptr, 0, 1};
            pg8::gemm_phase<pg8::EpiBf16S, pg8::GridOrder<2>, false, true>(ptid, lds + RING_OFF, xch, g, S, E);
            SEAM(pb + 6);
        }
        if (PH_ON(9) && IN(pb + 7)) {
            PHASE_TID(); unsigned char* ws = WSP(); float* X = (float*)ARGF(22);
            pg8::Gemm g{(const bf16_t*)(ws + WS_V), (const bf16_t*)(ws + WS_WCO) + (size_t)l * DM * DM, DM, DM, DM, nullptr};
            pg8::GridOrder<0> S; S.init(T / 256, DM / 256, G, bx, DM, DM);
            pg8::EpiResid E{X, X};
            pg8::gemm_phase<pg8::EpiResid, pg8::GridOrder<0>, false, true>(ptid, lds + RING_OFF, xch, g, S, E);
            SEAM(pb + 7);
        }
        if (PH_ON(10) && IN(pb + 8)) {
            PHASE_TID(); unsigned char* ws = WSP(); float* X = (float*)ARGF(22); bf16_t* XB = (bf16_t*)(ws + WS_XB); const int gw = vcu * NWAVES + wave; gu32* ctl = (gu32*)ws;
            const float* w_router = ARGF(14); const float* b_router = ARGF(15); const float* ln2_g = ARGF(12); const float* ln2_b = ARGF(13);
            int* ASGE = (int*)(ws + WS_ASGE); int* ASGR = (int*)(ws + WS_ASGR); float* ASGG = (float*)(ws + WS_ASGG); int* STOK = (int*)(ws + WS_STOK);
            const int tid = ptid;
            constexpr int RWS = 1028;
            LAS float* wl = (LAS float*)(lds + RING_OFF);
            LAS int* sE = (LAS int*)(lds + RING_OFF + NE * RWS * 4); LAS float* sG = (LAS float*)(sE + 512); LAS int* cntw = (LAS int*)(sG + 512); LAS int* basew = cntw + 256;
            { const float* wr_l = w_router + (size_t)l * DM * NE;
              for (int idx = tid; idx < DM * NE / 4; idx += NWAVES * 64) { const int k = idx >> 3, e4 = (idx & 7) * 4; const f32x4 w4 = *(const f32x4*)(wr_l + (size_t)k * NE + e4);
                  wl[(e4 + 0) * RWS + k] = w4[0]; wl[(e4 + 1) * RWS + k] = w4[1]; wl[(e4 + 2) * RWS + k] = w4[2]; wl[(e4 + 3) * RWS + k] = w4[3]; } }
            __syncthreads();
            gu32* cnt_l = ctl + CW_CNT + l * NE * 64;
            for (int rg = gw; rg < T / 16; rg += NGW) {
#pragma unroll 1
                for (int g4 = 0; g4 < 4; ++g4) {
                    int lo_ = lane; asm volatile("" : "+v"(lo_));
                    const int t0 = rg * 16 + g4 * 4; f32x4 xn[4][4];
                    { f32x4 gg[4], bb[4]; row_load(ln2_g + (size_t)l * DM, lo_, gg); row_load(ln2_b + (size_t)l * DM, lo_, bb);
#pragma unroll
                      for (int r = 0; r < 4; ++r) { const size_t t = (size_t)(t0 + r); row_load(X + t * DM, lo_, xn[r]); row_layernorm(xn[r], gg, bb);
                          row_store_f32(X + t * DM, lo_, xn[r]); row_store_bf16(XB + t * DM, lo_, xn[r]); } }
                    float vv[4]; const int eb = (lo_ >> 1) & 7;
#pragma unroll
                    for (int c = 0; c < 4; ++c) { const LAS float* wlo = wl + c * 8 * RWS; asm volatile("" : "+v"(wlo));
                        float acc[32]; thin_dot<8>(xn, wlo, RWS, lo_, acc); butterfly32(acc, lo_); vv[c] = acc[0] + b_router[l * NE + c * 8 + eb]; }
                    float topv[4]; int tope[4];
#pragma unroll
                    for (int k = 0; k < 4; ++k) { float bv = vv[0]; int be = eb;
#pragma unroll
                        for (int c = 1; c < 4; ++c) { if (vv[c] > bv) { bv = vv[c]; be = c * 8 + eb; } }
#pragma unroll
                        for (int o = 1; o < 16; o <<= 1) { const float ov = __shfl_xor(bv, o); const int oe = __shfl_xor(be, o); const bool take = (ov > bv) || (ov == bv && oe < be); bv = take ? ov : bv; be = take ? oe : be; }
                        topv[k] = bv; tope[k] = be;
#pragma unroll
                        for (int c = 0; c < 4; ++c) if (be == c * 8 + eb) vv[c] = -INFINITY; }
                    const float p1 = __expf(topv[1] - topv[0]), p2 = __expf(topv[2] - topv[0]), p3 = __expf(topv[3] - topv[0]); const float rs = 1.0f / (1.0f + p1 + p2 + p3);
                    const int kk = lo_ & 15;
                    if (kk < 4) { const int me = kk == 0 ? tope[0] : kk == 1 ? tope[1] : kk == 2 ? tope[2] : tope[3]; const float mg = (kk == 0 ? 1.0f : kk == 1 ? p1 : kk == 2 ? p2 : p3) * rs;
                        const int slot = wave * 64 + (g4 * 4 + (lo_ >> 4)) * 4 + kk; sE[slot] = me; sG[slot] = mg; }
                }
                LDS_WAIT();
                int lq_ = lane; asm volatile("" : "+v"(lq_));
                const int my_e = sE[wave * 64 + lq_]; const float my_g = sG[wave * 64 + lq_]; const int my_t = rg * 16 + (lq_ >> 2);
                int lr = 0, mycnt = 0;
#pragma unroll 1
                for (int e = 0; e < NE; ++e) { const unsigned long long m = __ballot(my_e == e); if (my_e == e) lr = __popcll(m & ((1ull << lq_) - 1ull)); if (lq_ == e) mycnt = __popcll(m); }
                if (lq_ < NE) cntw[wave * NE + lq_] = mycnt;
                __syncthreads();
                int tq_ = tid; asm volatile("" : "+v"(tq_));
                if (tq_ < NE) { int tot = 0; int c8[NWAVES];
#pragma unroll
                    for (int w = 0; w < NWAVES; ++w) { c8[w] = cntw[w * NE + tq_]; tot += c8[w]; }
                    int base = 0; if (tot > 0) base = (int)__hip_atomic_fetch_add(cnt_l + tq_ * 64, (unsigned)tot, __ATOMIC_RELAXED, __HIP_MEMORY_SCOPE_AGENT);
#pragma unroll
                    for (int w = 0; w < NWAVES; ++w) { basew[w * NE + tq_] = base; base += c8[w]; } }
                __syncthreads();
                const int rank = basew[wave * NE + my_e] + lr;
                ASGE[(size_t)my_t * 4 + (lq_ & 3)] = my_e; ASGR[(size_t)my_t * 4 + (lq_ & 3)] = rank; ASGG[(size_t)my_t * 4 + (lq_ & 3)] = my_g;
                STOK[(size_t)my_e * ECAP + rank] = my_t;
                __syncthreads();
            }
            SEAM(pb + 8);
        }
        if ((PH_ON(11) && IN(pb + 9)) || (PH_ON(12) && IN(pb + 10)) || (PH_ON(13) && IN(pb + 11))) {
            PHASE_TID(); gu32* ctl = (gu32*)WSP();
            __syncthreads();
            if (ptid < NE) CNT[ptid] = (int)__hip_atomic_load(ctl + CW_CNT + (l * NE + ptid) * 64, __ATOMIC_RELAXED, __HIP_MEMORY_SCOPE_AGENT);
            __syncthreads();
            if (ptid == 0) { int a = 0; for (int e = 0; e < NE; ++e) { TP[e] = a; a += (CNT[e] + 255) >> 8; } TP[NE] = a; }
            __syncthreads();
        }
        if (PH_ON(11) && IN(pb + 9)) {
            PHASE_TID(); unsigned char* ws = WSP();
            pg8::Gemm g{(const bf16_t*)(ws + WS_XB), (const bf16_t*)(ws + WS_WGU) + (size_t)l * NE * 2048 * DM, DM, DM, DM, (const int*)(ws + WS_STOK)};
            pg8::MoeOrder<8, true> S; S.init(TP, CNT, G, bx);
            pg8::EpiSwiglu E{(bf16_t*)(ws + WS_ACT), ARGF(17) + (size_t)l * NE * 2048};
            pg8::gemm_phase<pg8::EpiSwiglu, pg8::MoeOrder<8, true>, true, true>(ptid, lds + RING_OFF, xch, g, S, E);
            SEAM(pb + 9);
        }
        if (PH_ON(12) && IN(pb + 10)) {
            PHASE_TID(); unsigned char* ws = WSP();
            pg8::Gemm g{(const bf16_t*)(ws + WS_ACT), (const bf16_t*)(ws + WS_WD) + (size_t)l * NE * DM * DM, DM, DM, DM, nullptr};
            pg8::MoeOrder<4, false> S; S.init(TP, CNT, G, bx);
            pg8::EpiBf16S E{(bf16_t*)(ws + WS_YEXP), DM, 1.0f, ARGF(19) + (size_t)l * NE * DM, DM, 256};
            pg8::gemm_phase<pg8::EpiBf16S, pg8::MoeOrder<4, false>, false, true>(ptid, lds + RING_OFF, xch, g, S, E);
            SEAM(pb + 10);
        }
        if (PH_ON(13) && IN(pb + 11)) {
            PHASE_TID(); unsigned char* ws = WSP(); float* X = (float*)ARGF(22); const int gw = vcu * NWAVES + wave;
            bf16_t* XB = (bf16_t*)(ws + WS_XB); const int* ASGE = (const int*)(ws + WS_ASGE); const int* ASGR = (const int*)(ws + WS_ASGR); const float* ASGG = (const float*)(ws + WS_ASGG);
            const bf16_t* YEXP = (const bf16_t*)(ws + WS_YEXP); float* LOGF = (float*)(ws + WS_LOGF); const float* b_forget = ARGF(3);
            LAS float* wf = (LAS float*)(lds + RING_OFF);
            if (l + 1 < NL) { load_wf(ARGF(2) + (size_t)(l + 1) * DM * IN_COLS, wf, ptid); __syncthreads(); }
            f32x4 gg[4], bb[4]; row_load(ARGF(20) + (size_t)l * DM, lane, gg); row_load(ARGF(21) + (size_t)l * DM, lane, bb);
            for (int rg = gw; rg < T / 16; rg += NGW)
                for (int g4 = 0; g4 < 4; ++g4) { const int t0 = rg * 16 + g4 * 4; f32x4 xn[4][4];
#pragma unroll
                    for (int r = 0; r < 4; ++r) { const size_t t = (size_t)(t0 + r); row_load(X + t * DM, lane, xn[r]);
#pragma unroll
                        for (int j = 0; j < 4; ++j) xn[r][j] = xn[r][j] * DN_ALPHA;
#pragma unroll
                        for (int k = 0; k < 4; ++k) { const int e = ASGE[t * 4 + k], rk = ASGR[t * 4 + k]; const float gt = ASGG[t * 4 + k];
                            const GAS u32x2* yr = (const GAS u32x2*)(YEXP + ((size_t)TP[e] * 256 + rk) * DM) + lane;
#pragma unroll
                            for (int j = 0; j < 4; ++j) { const u32x2 w = yr[64 * j];
                                xn[r][j][0] += gt * __uint_as_float(w.x << 16); xn[r][j][1] += gt * __uint_as_float(w.x & 0xffff0000u);
                                xn[r][j][2] += gt * __uint_as_float(w.y << 16); xn[r][j][3] += gt * __uint_as_float(w.y & 0xffff0000u); } }
                        row_layernorm(xn[r], gg, bb); row_store_f32(X + t * DM, lane, xn[r]); row_store_bf16(XB + t * DM, lane, xn[r]); }
                    if (l + 1 < NL) forget_rows(xn, wf, b_forget + (l + 1) * 8, LOGF, t0, lane); }
            __syncthreads();
            SEAM(pb + 11);
        }
    }
#undef IN
#undef BOTH
#undef SEAM
}

#ifndef MK_PER_PHASE
#define MK_PER_PHASE 0
#endif
extern "C" void kernel_launch(void* const* d_in, const int* in_sizes, int n_in, void* d_out, int out_size, void* d_ws, size_t ws_size, hipStream_t stream) {
    static int grid = 0;
    if (grid == 0) {
        if (n_in != 22 || in_sizes[0] != T * DM || out_size != T * DM || ws_size < WS_END) {
            fprintf(stderr, "kernel_launch: built for 22 inputs, x/out of %d floats, >= %zu bytes of workspace; got n_in %d, in0 %d, out %d, ws %zu; nothing launched\n", T * DM, (size_t)WS_END, n_in, n_in > 0 ? in_sizes[0] : -1, out_size, ws_size); grid = -1; return; }
        int dev = 0, cus = 0, per_cu = 0;
        if (hipGetDevice(&dev) != hipSuccess || hipDeviceGetAttribute(&cus, hipDeviceAttributeMultiprocessorCount, dev) != hipSuccess) { fprintf(stderr, "kernel_launch: device query failed\n"); grid = -1; return; }
        if (hipFuncSetAttribute((const void*)skel_fwd, hipFuncAttributeMaxDynamicSharedMemorySize, LDS_BYTES) != hipSuccess) { fprintf(stderr, "kernel_launch: hipFuncSetAttribute failed\n"); grid = -1; return; }
        if (hipOccupancyMaxActiveBlocksPerMultiprocessor(&per_cu, (const void*)skel_fwd, NWAVES * 64, LDS_BYTES) != hipSuccess || per_cu < 1)
            fprintf(stderr, "kernel_launch: note: occupancy query reports %d workgroups per CU\n", per_cu);
        (void)hipGetLastError();
        grid = cus;
    }
    if (grid < 0) return;
    if (hipMemsetAsync((char*)d_ws + WS_CTL, 0, CTL_ZERO_BYTES, stream) != hipSuccess) { fprintf(stderr, "kernel_launch: memset failed\n"); return; }
    Args a{};
    for (int i = 0; i < 22; ++i) a.in[i] = (const float*)d_in[i];
    a.out = (float*)d_out; a.ws = (unsigned char*)d_ws;
#if MK_PER_PHASE
    for (int p = 0; p < NPHASE; ++p) { a.ph_lo = p; a.ph_hi = p + 1; hipLaunchKernelGGL(skel_fwd, dim3(grid), dim3(NWAVES * 64), LDS_BYTES, stream, a); }
#else
    a.ph_lo = 0; a.ph_hi = NPHASE; hipLaunchKernelGGL(skel_fwd, dim3(grid), dim3(NWAVES * 64), LDS_BYTES, stream, a);
#endif
    const hipError_t le = hipPeekAtLastError();
    if (le != hipSuccess) fprintf(stderr, "kernel_launch: launch failed: %s\n", hipGetErrorName(le));
}
```

```cpp
#define REPEAT_MASK 0
#include <hip/hip_runtime.h>
#include <cstdio>
#include <cstdint>
#include <cmath>

#define GAS __attribute__((address_space(1)))
#define LAS __attribute__((address_space(3)))
typedef unsigned short bf16_t;
typedef short bf16x8 __attribute__((ext_vector_type(8)));
typedef float f32x4 __attribute__((ext_vector_type(4)));
typedef float f32x2 __attribute__((ext_vector_type(2)));
typedef float f32x16 __attribute__((ext_vector_type(16)));
typedef unsigned u32x4 __attribute__((ext_vector_type(4)));
typedef unsigned u32x2 __attribute__((ext_vector_type(2)));
typedef short s16x4 __attribute__((ext_vector_type(4)));

constexpr int NB = 16, SEQ = 2048, DM = 1024, NL = 4, T = NB * SEQ;
constexpr int NMEM = 256, TM = NB * NMEM;
constexpr int NE = 32, TOPK = 4, TK = T * TOPK;
constexpr int IN_COLS = 3080, IN_N = 3072;
constexpr int FCOL = 1536;
constexpr float LN_EPS = 1e-5f;
constexpr float DN_ALPHA = 1.681792830507429f;
constexpr float LOG2E = 1.4426950408889634f;
constexpr float C2_ATT = 0.125f * LOG2E;
constexpr float C2_CROSS = 0.0625f * LOG2E;
constexpr int ECAP = 32768;
constexpr int MAXTILES = 544;

__device__ __forceinline__ unsigned cvt_pk_bf16(float lo, float hi) { unsigned r; asm volatile("v_cvt_pk_bf16_f32 %0, %1, %2" : "=v"(r) : "v"(lo), "v"(hi)); return r; }
__device__ __forceinline__ float bf2f(unsigned short b) { return __uint_as_float((unsigned)b << 16); }
#include <hip/hip_bf16.h>
typedef GAS unsigned gu32;
typedef GAS unsigned long long gu64;
#define RLX_AGENT __ATOMIC_RELAXED, __HIP_MEMORY_SCOPE_AGENT
namespace pg8 {
constexpr int BM = 256, BK = 64, HALF = 128, HTB = HALF * BK * 2  , STAGE_BYTES = 8 * HTB, NXCD = 8, WGM = 8;

__host__ __device__ __forceinline__ int lds_byte(int r, int c) { const int st = (r >> 4) * 2 + (c >> 5), rr = r & 15, cc = c & 31, ob = rr * 64 + cc * 2; return st * 1024 + (ob ^ (((ob >> 9) & 1) << 5)); }
__host__ __device__ __forceinline__ void stage_rc(int b, int& R, int& C) { const int st = b / 1024, sb = b % 1024, swz = sb ^ (((sb >> 9) & 1) << 5); R = (st >> 1) * 16 + swz / 64; C = (st & 1) * 32 + (swz % 64) / 2; }
__host__ __device__ __forceinline__ int perm32(int rho) { const int n = rho >> 4, i = rho & 15; return 8 * (i >> 2) + 4 * n + (i & 3); }

struct Unit { long abyte, bbyte; int orow, ocol, aux, grow, gcnt; };
struct Gemm { const bf16_t* A; const bf16_t* Bt; int lda, ldb, K; const int* gtok; };

__device__ __forceinline__ int xcd_chunk(int L, int nwg) { const int q = nwg / NXCD, r = nwg % NXCD, xcd = L % NXCD, off = L / NXCD; return (xcd < r ? xcd * (q + 1) : r * (q + 1) + (xcd - r) * q) + off; }

template <int MODE> struct GridOrder {
    int nM, nN, nwg, G, c, lda, ldb;
    __device__ __forceinline__ void init(int nM_, int nN_, int G_, int c_, int lda_, int ldb_) { nM = nM_; nN = nN_; nwg = nM * nN; G = G_; c = c_; lda = lda_; ldb = ldb_; }
    __device__ __forceinline__ bool next(int i, Unit& u) const {
        const long L = (long)i * G + c; if (L >= nwg) return false;
        const int wgid = xcd_chunk((int)L, nwg);
        const int nig = WGM * nN, gid = wgid / nig, fm = gid * WGM, gsz = (nM - fm) < WGM ? (nM - fm) : WGM;
        const int pm = fm + ((wgid % nig) % gsz), pn = (wgid % nig) / gsz;
        u.orow = pm * BM; u.ocol = pn * BM; u.aux = pn; u.grow = 0; u.gcnt = BM;
        if (MODE == 0) { u.abyte = (long)pm * BM * lda * 2; u.bbyte = (long)pn * BM * ldb * 2; }
        else { const int b = pm >> 3; u.abyte = (long)pm * BM * lda * 2 + pn * 512;
               u.bbyte = (MODE == 1) ? ((long)b * 256 * ldb + pn * 256) * 2 : ((long)pn * 256 * ldb + b * 256) * 2; }
        return true;
    }
};
template <int NPN, bool GATHER> struct MoeOrder {
    const LAS int* tp; const LAS int* cnt; int nwg, G, c;
    __device__ __forceinline__ void init(const LAS int* tp_, const LAS int* cnt_, int G_, int c_) { tp = tp_; cnt = cnt_; G = G_; c = c_; nwg = __builtin_amdgcn_readfirstlane(tp_[32]) * NPN; }
    __device__ __forceinline__ bool next(int i, Unit& u) const {
        const long L = (long)i * G + c; if (L >= nwg) return false;
        const int wgid = xcd_chunk((int)L, nwg);
        int e = 0;
#pragma unroll
        for (int k = 16; k >= 1; k >>= 1) { const int v = __builtin_amdgcn_readfirstlane(tp[e + k]); if (v * NPN <= wgid) e += k; }
        const int t0 = __builtin_amdgcn_readfirstlane(tp[e]), t1 = __builtin_amdgcn_readfirstlane(tp[e + 1]), ce = __builtin_amdgcn_readfirstlane(cnt[e]);
        const int r = wgid - t0 * NPN, nte = t1 - t0, j = r % nte, pn = r / nte;
        u.aux = e; u.grow = e * ECAP + j * BM; u.gcnt = (ce - j * BM) < BM ? (ce - j * BM) : BM;
        u.orow = (t0 + j) * BM; u.ocol = pn;
        u.abyte = GATHER ? 0 : (long)(t0 + j) * BM * DM * 2;
        u.bbyte = (long)(e * NPN + pn) * BM * DM * 2;
        return true;
    }
};

struct EpiCtx { int wr, wc, fr, fq, wid, lane; LAS unsigned char* xch; };

struct EpiQKV {
    static constexpr bool PERM = true;
    bf16_t *Q, *K, *V; float* kpart;
    __device__ __forceinline__ void operator()(const f32x4 (&acc)[2][2][4][2], const Unit& u, const EpiCtx& c) const {
        const int pn = u.aux, ts = (pn >> 1) % 3, grp = pn / 6;
        bf16_t* base = (ts == 0) ? Q : ((ts == 1) ? K : V);
        const float sc = (ts == 0) ? C2_ATT : 1.f;
        const int row0 = u.orow + c.wr * 64 + c.fr, col0 = grp * 512 + (pn & 1) * 256 + c.wc * 32 + 8 * c.fq;
#pragma unroll
        for (int ai = 0; ai < 2; ++ai)
#pragma unroll
            for (int m = 0; m < 4; ++m) { bf16_t* rowp = base + (size_t)(row0 + ai * HALF + m * 16) * DM + col0;
#pragma unroll
                for (int bj = 0; bj < 2; ++bj) { const f32x4 v0 = acc[ai][bj][m][0] * sc, v1 = acc[ai][bj][m][1] * sc;
                    u32x4 w; w.x = cvt_pk_bf16(v0[0], v0[1]); w.y = cvt_pk_bf16(v0[2], v0[3]); w.z = cvt_pk_bf16(v1[0], v1[1]); w.w = cvt_pk_bf16(v1[2], v1[3]);
                    *(u32x4*)(rowp + bj * HALF) = w; } }
        if (pn == 8 || pn == 9) {
#pragma unroll
            for (int bj = 0; bj < 2; ++bj)
#pragma unroll
                for (int n = 0; n < 2; ++n) { f32x4 s = (f32x4){0.f, 0.f, 0.f, 0.f};
#pragma unroll
                    for (int ai = 0; ai < 2; ++ai)
#pragma unroll
                        for (int m = 0; m < 4; ++m) s += acc[ai][bj][m][n];
#pragma unroll
                    for (int o = 1; o < 16; o <<= 1) { s[0] += __shfl_xor(s[0], o); s[1] += __shfl_xor(s[1], o); s[2] += __shfl_xor(s[2], o); s[3] += __shfl_xor(s[3], o); }
                    if (c.fr == 0) *(f32x4*)(kpart + (size_t)((u.orow >> 8) * 2 + c.wr) * 512 + (pn - 8) * 256 + bj * HALF + c.wc * 32 + 8 * c.fq + 4 * n) = s; }
        }
    }
};
struct EpiResid {
    static constexpr bool PERM = false;
    const float* res; float* out;
    __device__ __forceinline__ void operator()(const f32x4 (&acc)[2][2][4][2], const Unit& u, const EpiCtx& c) const {
        const int row0 = u.orow + c.wr * 64 + c.fr, col0 = u.ocol + c.wc * 32 + 4 * c.fq;
#pragma unroll
        for (int ai = 0; ai < 2; ++ai)
#pragma unroll
            for (int m = 0; m < 4; ++m) { const size_t off = (size_t)(row0 + ai * HALF + m * 16) * DM + col0;
#pragma unroll
                for (int bj = 0; bj < 2; ++bj)
#pragma unroll
                    for (int n = 0; n < 2; ++n) { const f32x4 r = *(const f32x4*)(res + off + bj * HALF + n * 16); *(f32x4*)(out + off + bj * HALF + n * 16) = r * DN_ALPHA + acc[ai][bj][m][n]; } }
    }
};
struct EpiBf16S {
    static constexpr bool PERM = true;
    bf16_t* O; int ldc; float scale; const float* bias; int bstride; int cmul;
    __device__ __forceinline__ void operator()(const f32x4 (&acc)[2][2][4][2], const Unit& u, const EpiCtx& c) const {
        const int row0 = u.orow + c.wr * 64 + c.fr, col0 = u.ocol * cmul + c.wc * 32 + 8 * c.fq;
        f32x4 bv[2][2];
#pragma unroll
        for (int bj = 0; bj < 2; ++bj)
#pragma unroll
            for (int n = 0; n < 2; ++n) bv[bj][n] = bias ? *(const f32x4*)(bias + (size_t)u.aux * bstride + col0 + bj * HALF + 4 * n) : (f32x4){0.f, 0.f, 0.f, 0.f};
#pragma unroll
        for (int ai = 0; ai < 2; ++ai)
#pragma unroll
            for (int m = 0; m < 4; ++m) { bf16_t* rowp = O + (size_t)(row0 + ai * HALF + m * 16) * ldc + col0;
#pragma unroll
                for (int bj = 0; bj < 2; ++bj) { const f32x4 v0 = (acc[ai][bj][m][0] + bv[bj][0]) * scale, v1 = (acc[ai][bj][m][1] + bv[bj][1]) * scale;
                    u32x4 w; w.x = cvt_pk_bf16(v0[0], v0[1]); w.y = cvt_pk_bf16(v0[2], v0[3]); w.z = cvt_pk_bf16(v1[0], v1[1]); w.w = cvt_pk_bf16(v1[2], v1[3]);
                    *(u32x4*)(rowp + bj * HALF) = w; } }
    }
};
struct EpiSwiglu {
    static constexpr bool PERM = true;
    bf16_t* O; const float* bias;
    __device__ __forceinline__ void operator()(const f32x4 (&acc)[2][2][4][2], const Unit& u, const EpiCtx& c) const {
        const int row0 = u.orow + c.wr * 64 + c.fr, col0 = u.ocol * HALF + c.wc * 32 + 8 * c.fq;
        const float* bp = bias + (size_t)u.aux * 2048 + col0;
        f32x4 bg[2], bu[2];
#pragma unroll
        for (int n = 0; n < 2; ++n) { bg[n] = *(const f32x4*)(bp + 4 * n); bu[n] = *(const f32x4*)(bp + 1024 + 4 * n); }
#pragma unroll
        for (int ai = 0; ai < 2; ++ai)
#pragma unroll
            for (int m = 0; m < 4; ++m) { float o[8];
#pragma unroll
                for (int n = 0; n < 2; ++n)
#pragma unroll
                    for (int i = 0; i < 4; ++i) { float gv = acc[ai][0][m][n][i] + bg[n][i], uv = acc[ai][1][m][n][i] + bu[n][i];
                        gv = fminf(gv, 7.0f); uv = fminf(fmaxf(uv, -7.0f), 7.0f);
                        const float sg = __builtin_amdgcn_rcpf(1.0f + __builtin_amdgcn_exp2f(gv * (-1.702f * LOG2E)));
                        o[n * 4 + i] = (uv + 1.0f) * (gv * sg); }
                u32x4 w; w.x = cvt_pk_bf16(o[0], o[1]); w.y = cvt_pk_bf16(o[2], o[3]); w.z = cvt_pk_bf16(o[4], o[5]); w.w = cvt_pk_bf16(o[6], o[7]);
                *(u32x4*)(O + (size_t)(row0 + ai * HALF + m * 16) * DM + col0) = w; }
    }
};
struct EpiSoftmax {
    static constexpr bool PERM = true;
    bf16_t* O;
    __device__ __forceinline__ void operator()(f32x4 (&acc)[2][2][4][2], const Unit& u, const EpiCtx& c0) const {
        EpiCtx c = c0; asm volatile("" : "+v"(c.fr), "+v"(c.fq));
        LAS float* MX = (LAS float*)c.xch;
        LAS float* SM = (LAS float*)(c.xch + 4096);
#pragma unroll
        for (int ai = 0; ai < 2; ++ai)
#pragma unroll
            for (int m = 0; m < 4; ++m) { float mx = -INFINITY;
#pragma unroll
                for (int bj = 0; bj < 2; ++bj)
#pragma unroll
                    for (int n = 0; n < 2; ++n) { const f32x4 x = acc[ai][bj][m][n]; mx = fmaxf(mx, fmaxf(fmaxf(x[0], x[1]), fmaxf(x[2], x[3]))); }
                mx = fmaxf(mx, __shfl_xor(mx, 16)); mx = fmaxf(mx, __shfl_xor(mx, 32));
                if (c.fq == 0) MX[(ai * HALF + c.wr * 64 + m * 16 + c.fr) * 4 + c.wc] = mx; }
        asm volatile("s_waitcnt lgkmcnt(0)" ::: "memory"); __builtin_amdgcn_s_barrier(); asm volatile("" ::: "memory");
#pragma unroll
        for (int ai = 0; ai < 2; ++ai)
#pragma unroll
            for (int m = 0; m < 4; ++m) { const int r = ai * HALF + c.wr * 64 + m * 16 + c.fr; const f32x4 mm = *(const LAS f32x4*)(MX + r * 4);
                const float mx = fmaxf(fmaxf(mm[0], mm[1]), fmaxf(mm[2], mm[3])); float s = 0.f;
#pragma unroll
                for (int bj = 0; bj < 2; ++bj)
#pragma unroll
                    for (int n = 0; n < 2; ++n) { f32x4 x = acc[ai][bj][m][n];
                        x[0] = __builtin_amdgcn_exp2f(x[0] - mx); x[1] = __builtin_amdgcn_exp2f(x[1] - mx); x[2] = __builtin_amdgcn_exp2f(x[2] - mx); x[3] = __builtin_amdgcn_exp2f(x[3] - mx);
                        s += (x[0] + x[1]) + (x[2] + x[3]); acc[ai][bj][m][n] = x; }
                s += __shfl_xor(s, 16); s += __shfl_xor(s, 32);
                if (c.fq == 0) SM[r * 4 + c.wc] = s; __builtin_amdgcn_sched_barrier(0); }
        asm volatile("s_waitcnt lgkmcnt(0)" ::: "memory"); __builtin_amdgcn_s_barrier(); asm volatile("" ::: "memory");
        const int row0 = u.orow + c.wr * 64 + c.fr, col0 = u.ocol + c.wc * 32 + 8 * c.fq;
#pragma unroll
        for (int ai = 0; ai < 2; ++ai)
#pragma unroll
            for (int m = 0; m < 4; ++m) { const int r = ai * HALF + c.wr * 64 + m * 16 + c.fr; const f32x4 ss = *(const LAS f32x4*)(SM + r * 4);
                const float rl = 1.0f / ((ss[0] + ss[1]) + (ss[2] + ss[3]));
                bf16_t* rowp = O + (size_t)(row0 + ai * HALF + m * 16) * DM + col0;
#pragma unroll
                for (int bj = 0; bj < 2; ++bj) { const f32x4 v0 = acc[ai][bj][m][0] * rl, v1 = acc[ai][bj][m][1] * rl;
                    u32x4 w; w.x = cvt_pk_bf16(v0[0], v0[1]); w.y = cvt_pk_bf16(v0[2], v0[3]); w.z = cvt_pk_bf16(v1[0], v1[1]); w.w = cvt_pk_bf16(v1[2], v1[3]);
                    *(u32x4*)(rowp + bj * HALF) = w; } __builtin_amdgcn_sched_barrier(0); }
    }
};

template <class Epi, class Sched, bool GATHER, bool ALIGN_EPI>
__device__ __forceinline__ void gemm_phase(int tid, LAS unsigned char* lds, LAS unsigned char* xch, const Gemm g, const Sched& S, const Epi& E) {
    const int wid = __builtin_amdgcn_readfirstlane(tid >> 6), lane = tid & 63, wr = wid >> 2, wc = wid & 3, fr = lane & 15, fq = lane >> 4;
    int Kv = g.K; asm volatile("" : "+s"(Kv));
    const int nt = Kv / BK;
    EpiCtx ctx; ctx.wr = wr; ctx.wc = wc; ctx.fr = fr; ctx.fq = fq; ctx.wid = wid; ctx.lane = lane; ctx.xch = xch;
    unsigned oB[2], oAc[2][2], oAn[2][2];
#pragma unroll
    for (int i = 0; i < 2; ++i) { int R, C; stage_rc(tid * 16 + i * 8192, R, C); const int Rb = Epi::PERM ? ((R & ~31) + perm32(R & 31)) : R;
        oB[i] = (unsigned)(Rb * g.ldb + C) * 2u;
        oAc[0][i] = (unsigned)(R * g.lda + C) * 2u; oAc[1][i] = oAc[0][i] + (unsigned)(HALF * g.lda * 2); oAn[0][i] = oAc[0][i]; oAn[1][i] = oAc[1][i]; }
    const size_t kstep = (size_t)(BK * 2);
    const size_t hstepB = (size_t)HALF * g.ldb * 2;
    const unsigned ldsw = (unsigned)wid * 1024u;
    const int aoff = lds_byte(wr * 64 + fr, fq * 8), boff = lds_byte(wc * 32 + fr, fq * 8);
#define PG8_SA(b, h) (((b) * 2 + (h)) * HTB)
#define PG8_SB(b, h) ((4 + (b) * 2 + (h)) * HTB)
#define PG8_STAGE(bufoff, gbase, o0, o1) do { \
        __builtin_amdgcn_global_load_lds((const unsigned*)((const char*)(gbase) + (o0)), (LAS unsigned*)(lds + (bufoff) + ldsw), 16, 0, 0); \
        __builtin_amdgcn_global_load_lds((const unsigned*)((const char*)(gbase) + (o1)), (LAS unsigned*)(lds + (bufoff) + ldsw + 8192), 16, 0, 0); } while (0)
#define PG8_STAGE_B(bufoff, gbase) PG8_STAGE(bufoff, gbase, oB[0], oB[1])
#define PG8_LDA(dst, b, h) do { _Pragma("unroll") for (int m = 0; m < 4; ++m) _Pragma("unroll") for (int k = 0; k < 2; ++k) dst[m][k] = *(const LAS bf16x8*)(lds + PG8_SA(b, h) + aoff + m * 2048 + k * 1024); } while (0)
#define PG8_LDB(dst, b, h) do { _Pragma("unroll") for (int n = 0; n < 2; ++n) _Pragma("unroll") for (int k = 0; k < 2; ++k) dst[n][k] = *(const LAS bf16x8*)(lds + PG8_SB(b, h) + boff + n * 2048 + k * 1024); } while (0)
#define PG8_MMA(ai, bj, At, Bt) do { __builtin_amdgcn_s_setprio(1); _Pragma("unroll") for (int m = 0; m < 4; ++m) _Pragma("unroll") for (int n = 0; n < 2; ++n) _Pragma("unroll") for (int k = 0; k < 2; ++k) \
        acc[ai][bj][m][n] = __builtin_amdgcn_mfma_f32_16x16x32_bf16(Bt[n][k], At[m][k], acc[ai][bj][m][n], 0, 0, 0); __builtin_amdgcn_s_setprio(0); } while (0)
#define PG8_WAIT_V(n) asm volatile("s_waitcnt vmcnt(" #n ")" ::: "memory")
#define PG8_WAIT_L(n) asm volatile("s_waitcnt lgkmcnt(" #n ")" ::: "memory")
#define PG8_BAR __builtin_amdgcn_s_barrier()
#define PG8_SCHED __builtin_amdgcn_sched_barrier(0)
#define PG8_TOK_LOAD(U, tk) do { int t_ = tid; asm volatile("" : "+v"(t_)); _Pragma("unroll") for (int i = 0; i < 2; ++i) { int R_, C_; stage_rc(t_ * 16 + i * 8192, R_, C_); _Pragma("unroll") for (int h = 0; h < 2; ++h) { \
        const int r_ = h * HALF + R_; tk[h][i] = (r_ < (U).gcnt) ? ((const GAS int*)g.gtok)[(U).grow + r_] : 0; } } } while (0)
#define PG8_TOK_OFF(tk, set) do { int t_ = tid; asm volatile("" : "+v"(t_)); _Pragma("unroll") for (int i = 0; i < 2; ++i) { int R_, C_; stage_rc(t_ * 16 + i * 8192, R_, C_); _Pragma("unroll") for (int h = 0; h < 2; ++h) { \
        set[h][i] = (unsigned)(tk[h][i] * g.lda + C_) * 2u; asm volatile("" : "+v"(set[h][i])); } } } while (0)
    Unit cur, nxt, nn; int ui = 0;
    if (!S.next(0, cur)) return;
    bool has_next = S.next(1, nxt);
    if constexpr (GATHER) {
        int tk[2][2]; PG8_TOK_LOAD(cur, tk); PG8_TOK_OFF(tk, oAc);
        if (has_next) { PG8_TOK_LOAD(nxt, tk); PG8_TOK_OFF(tk, oAn); }
        else {
#pragma unroll
            for (int h = 0; h < 2; ++h)
#pragma unroll
                for (int i = 0; i < 2; ++i) oAn[h][i] = oAc[h][i]; }
    }
    f32x4 acc[2][2][4][2];
#pragma unroll
    for (int a = 0; a < 2; ++a)
#pragma unroll
        for (int b = 0; b < 2; ++b)
#pragma unroll
            for (int m = 0; m < 4; ++m)
#pragma unroll
                for (int n = 0; n < 2; ++n) acc[a][b][m][n] = (f32x4){0.f, 0.f, 0.f, 0.f};
    bf16x8 At[4][2], B0[2][2], B1[2][2];
    const char* cA = (const char*)g.A + cur.abyte; const char* cB = (const char*)g.Bt + cur.bbyte;
    PG8_STAGE_B(PG8_SB(0, 0), cB); PG8_STAGE_B(PG8_SB(0, 1), cB + hstepB); PG8_STAGE(PG8_SA(0, 0), cA, oAc[0][0], oAc[0][1]); PG8_STAGE(PG8_SA(0, 1), cA, oAc[1][0], oAc[1][1]);
    if (wr == 1) PG8_BAR;
    PG8_WAIT_V(2); PG8_BAR;
    PG8_STAGE_B(PG8_SB(1, 0), cB + kstep); PG8_STAGE(PG8_SA(1, 0), cA + kstep, oAc[0][0], oAc[0][1]); PG8_STAGE_B(PG8_SB(1, 1), cB + hstepB + kstep);
    PG8_WAIT_V(6); PG8_BAR;
    for (;;) {
        bool has_nn = false;
        if (has_next) has_nn = S.next(ui + 2, nn);
        int tkp[2][2];
        if constexpr (GATHER) { if (has_nn) { PG8_TOK_LOAD(nn, tkp); } }
        const char* nA = has_next ? (const char*)g.A + nxt.abyte : cA; const char* nB = has_next ? (const char*)g.Bt + nxt.bbyte : cB;
        for (int t = 0; t < nt; t += 2) {
            const bool last = (t == nt - 2);
            const char* a1 = cA + (size_t)(t + 1) * kstep;
            const char* a2 = last ? nA : cA + (size_t)(t + 2) * kstep; const char* b2 = last ? nB : cB + (size_t)(t + 2) * kstep;
            const char* a3 = a2 + kstep; const char* b3 = b2 + kstep;
            unsigned o2[2][2];
#pragma unroll
            for (int h = 0; h < 2; ++h)
#pragma unroll
                for (int i = 0; i < 2; ++i) o2[h][i] = GATHER ? (last ? oAn[h][i] : oAc[h][i]) : oAc[h][i];
            PG8_LDB(B0, 0, 0); PG8_LDB(B1, 0, 1); PG8_SCHED; PG8_LDA(At, 0, 0); PG8_STAGE(PG8_SA(1, 1), a1, oAc[1][0], oAc[1][1]);
            PG8_WAIT_V(8); PG8_WAIT_L(0); PG8_BAR; PG8_MMA(0, 0, At, B0); PG8_MMA(0, 1, At, B1); PG8_BAR; PG8_SCHED;
            PG8_LDA(At, 0, 1); PG8_STAGE_B(PG8_SB(0, 0), b2); PG8_STAGE_B(PG8_SB(0, 1), b2 + hstepB); PG8_STAGE(PG8_SA(0, 0), a2, o2[0][0], o2[0][1]);
            PG8_WAIT_V(8); PG8_WAIT_L(0); PG8_BAR; PG8_MMA(1, 0, At, B0); PG8_MMA(1, 1, At, B1); PG8_BAR; PG8_SCHED;
            PG8_LDB(B0, 1, 0); PG8_LDB(B1, 1, 1); PG8_SCHED; PG8_LDA(At, 1, 0); PG8_STAGE(PG8_SA(0, 1), a2, o2[1][0], o2[1][1]);
            PG8_WAIT_V(8); PG8_WAIT_L(0); PG8_BAR; PG8_MMA(0, 0, At, B0); PG8_MMA(0, 1, At, B1); PG8_BAR; PG8_SCHED;
            PG8_LDA(At, 1, 1); PG8_STAGE_B(PG8_SB(1, 0), b3); PG8_STAGE_B(PG8_SB(1, 1), b3 + hstepB); PG8_STAGE(PG8_SA(1, 0), a3, o2[0][0], o2[0][1]);
            PG8_WAIT_V(8); PG8_WAIT_L(0); PG8_BAR; PG8_MMA(1, 0, At, B0); PG8_MMA(1, 1, At, B1); PG8_BAR; PG8_SCHED;
        }
        if constexpr (ALIGN_EPI) { if (wr == 0) PG8_BAR; }
        E(acc, cur, ctx);
        if (!has_next) break;
#pragma unroll
        for (int a = 0; a < 2; ++a)
#pragma unroll
            for (int b = 0; b < 2; ++b)
#pragma unroll
                for (int m = 0; m < 4; ++m)
#pragma unroll
                    for (int n = 0; n < 2; ++n) acc[a][b][m][n] = (f32x4){0.f, 0.f, 0.f, 0.f};
        cur = nxt; cA = nA; cB = nB; ++ui; nxt = nn; has_next = has_nn;
        if constexpr (GATHER) {
#pragma unroll
            for (int h = 0; h < 2; ++h)
#pragma unroll
                for (int i = 0; i < 2; ++i) oAc[h][i] = oAn[h][i];
            if (has_next) { PG8_TOK_OFF(tkp, oAn); }
        }
        if constexpr (ALIGN_EPI) { if (wr == 1) PG8_BAR; }
    }
    PG8_WAIT_V(0);
    if constexpr (!ALIGN_EPI) { if (wr == 0) PG8_BAR; }
    PG8_BAR;
#undef PG8_SA
#undef PG8_SB
#undef PG8_STAGE
#undef PG8_STAGE_B
#undef PG8_LDA
#undef PG8_LDB
#undef PG8_MMA
#undef PG8_WAIT_V
#undef PG8_WAIT_L
#undef PG8_BAR
#undef PG8_SCHED
#undef PG8_TOK_LOAD
#undef PG8_TOK_OFF
}
}
namespace attn_body {
using bf16=__hip_bfloat16;
using bf16x8=__attribute__((ext_vector_type(8)))short;
using s16x4=__attribute__((ext_vector_type(4)))short;
using f32x16=__attribute__((ext_vector_type(16)))float;
using u32x4=__attribute__((ext_vector_type(4)))unsigned;
constexpr int BATCH=16,NHEAD=16,SEQ=2048,D=64,DM=NHEAD*D;
constexpr int NW=8,QBLK=32,QB=QBLK*NW,KVBLK=64,NQB=SEQ/QB;
constexpr int ATTN_PITCH=DM, ATTN_UNIT_ROWS=QB;
__device__ __forceinline__ int crow(int r,int hi){return (r&3)+8*(r>>2)+4*hi;}
#define SBAR() __builtin_amdgcn_sched_barrier(0)
__device__ __forceinline__ void cmask(f32x16&p0,f32x16&p1,int jb,int qrel,int hi){
  const float NEG=-INFINITY; const int qd=qrel-64*jb-4*hi;
  #pragma unroll
  for(int r=0;r<16;++r){const int c=(r&3)+8*(r>>2); if(c>qd)p0[r]=NEG; if(c+32>qd)p1[r]=NEG;}
}

constexpr int NSLOT=3, SLOTB=8192;
constexpr int LDS_K=0, LDS_V=NSLOT*SLOTB, LDS_WS=2*NSLOT*SLOTB, LDS_OST=LDS_WS+NW*64*4, LDS_TAB=LDS_OST+NW*4096, LDS_BYTES=LDS_TAB+8192;
constexpr float C2=0.125f*1.4426950408889634f;
__device__ __forceinline__ void glds16(const void*gsrc,unsigned lds_dst){unsigned keep;
  asm volatile("s_mov_b32 %0, m0\n\ts_mov_b32 m0, %2\n\ts_nop 0\n\tglobal_load_lds_dwordx4 %1, off\n\ts_mov_b32 m0, %0":"=&s"(keep):"v"(gsrc),"s"(lds_dst):"memory");}
__device__ __forceinline__ float max3f(float a,float b,float c){float r;asm("v_max3_f32 %0, %1, %2, %3":"=v"(r):"v"(a),"v"(b),"v"(c));return r;}
__device__ __forceinline__ float max2f(float a,float b){float r;asm("v_max_f32_e32 %0, %1, %2":"=v"(r):"v"(a),"v"(b));return r;}
__device__ __forceinline__ float fadd_s(float a,float b){float r;asm("v_add_f32_e32 %0, %1, %2":"=v"(r):"v"(a),"v"(b));return r;}
__device__ __forceinline__ float fsub_s(float a,float b){float r;asm("v_sub_f32_e32 %0, %1, %2":"=v"(r):"v"(a),"v"(b));return r;}
typedef float f32x2_t __attribute__((ext_vector_type(2))); typedef float f32x4_t __attribute__((ext_vector_type(4))); typedef __bf16 bf16x2_t __attribute__((ext_vector_type(2)));
__device__ __forceinline__ unsigned cvtpk_s(float lo,float hi){f32x2_t v={lo,hi};bf16x2_t b=__builtin_convertvector(v,bf16x2_t);return __builtin_bit_cast(unsigned,b);}
#define WAIT_BAR(N) asm volatile("s_waitcnt vmcnt(" #N ") lgkmcnt(0)\n\ts_barrier":::"memory")

__device__ __forceinline__ void qkt(f32x16&p0,f32x16&p1,const char*Kslot,const bf16x8*qr,int r32,int hi){
  const char*kb=Kslot+hi*1024+r32*16;
  #pragma unroll
  for(int d0=0;d0<4;++d0){
    const bf16x8 b0=*reinterpret_cast<const bf16x8*>(kb+d0*2048);
    const bf16x8 b1=*reinterpret_cast<const bf16x8*>(kb+d0*2048+512);
    {p0=__builtin_amdgcn_mfma_f32_32x32x16_bf16(b0,qr[d0],p0,0,0,0);p1=__builtin_amdgcn_mfma_f32_32x32x16_bf16(b1,qr[d0],p1,0,0,0);}}
}
typedef __attribute__((address_space(3))) const char* lds_cptr;
typedef short v4i16_t __attribute__((ext_vector_type(4)));
__device__ __forceinline__ void kload8(bf16x8*kf,lds_cptr kp){
  kf[0]=*(const __attribute__((address_space(3))) bf16x8*)(kp);      kf[1]=*(const __attribute__((address_space(3))) bf16x8*)(kp+512);
  kf[2]=*(const __attribute__((address_space(3))) bf16x8*)(kp+2048); kf[3]=*(const __attribute__((address_space(3))) bf16x8*)(kp+2560);
  kf[4]=*(const __attribute__((address_space(3))) bf16x8*)(kp+4096); kf[5]=*(const __attribute__((address_space(3))) bf16x8*)(kp+4608);
  kf[6]=*(const __attribute__((address_space(3))) bf16x8*)(kp+6144); kf[7]=*(const __attribute__((address_space(3))) bf16x8*)(kp+6656);
}
__device__ __forceinline__ void kload2(bf16x8*kf,lds_cptr kp,int j){ kf[2*j]=*(const __attribute__((address_space(3))) bf16x8*)(kp+j*2048); kf[2*j+1]=*(const __attribute__((address_space(3))) bf16x8*)(kp+j*2048+512); }
__device__ __forceinline__ s16x4 vtr(lds_cptr p){ return __builtin_bit_cast(s16x4,__builtin_amdgcn_ds_read_tr16_b64_v4i16((__attribute__((address_space(3))) v4i16_t*)p)); }
__device__ __forceinline__ float rowmax(const f32x16&p0,const f32x16&p1){
  float a=max3f(p0[0],p0[1],p1[0]),b=max3f(p0[2],p0[3],p1[1]);a=max3f(a,p1[2],p1[3]);
  #pragma unroll
  for(int r=4;r<16;r+=4){a=max3f(a,p0[r],p0[r+1]);b=max3f(b,p0[r+2],p0[r+3]);a=max3f(a,p1[r],p1[r+1]);b=max3f(b,p1[r+2],p1[r+3]);}
  const float m=max2f(a,b);
  auto rr=__builtin_amdgcn_permlane32_swap(__float_as_uint(m),__float_as_uint(m),false,false);
  return max2f(__uint_as_float(rr[0]),__uint_as_float(rr[1]));
}
__device__ __forceinline__ void pv(f32x16*o,int vb,bf16x8 pa0,bf16x8 pa1,bf16x8 pa2,bf16x8 pa3){
  #pragma unroll
  for(int d0=0;d0<2;++d0){s16x4 lo[4],hi[4];
    #pragma unroll
    for(int ks=0;ks<4;++ks){
      asm volatile("ds_read_b64_tr_b16 %0,%1 offset:%c2":"=&v"(lo[ks]):"v"(vb),"i"(d0*4096+ks*1024):"memory");
      asm volatile("ds_read_b64_tr_b16 %0,%1 offset:%c2":"=&v"(hi[ks]):"v"(vb),"i"(d0*4096+ks*1024+512):"memory");}
    asm volatile("s_waitcnt lgkmcnt(0)":::"memory");SBAR();
    #define PK(k) (bf16x8){lo[k][0],lo[k][1],lo[k][2],lo[k][3],hi[k][0],hi[k][1],hi[k][2],hi[k][3]}
    o[d0]=__builtin_amdgcn_mfma_f32_32x32x16_bf16(pa0,PK(0),o[d0],0,0,0);
    o[d0]=__builtin_amdgcn_mfma_f32_32x32x16_bf16(pa1,PK(1),o[d0],0,0,0);
    o[d0]=__builtin_amdgcn_mfma_f32_32x32x16_bf16(pa2,PK(2),o[d0],0,0,0);
    o[d0]=__builtin_amdgcn_mfma_f32_32x32x16_bf16(pa3,PK(3),o[d0],0,0,0);
    #undef PK
  }
}

#ifndef ATTN_STORE16
#define ATTN_STORE16(p,v) (*(u32x4*)(p)=(v))
#endif
struct AttnExtra { const float* kbias; const float* kpart; const float* relb; };
template<int THRL,int MODE> __device__ __forceinline__ void attn_unit(int b,int h,int qb,const bf16*Q,const bf16*__restrict__ K,const bf16*__restrict__ V,bf16*O,char*shm,const AttnExtra&X,const int tid){
  const int lane=tid&63,r32=lane&31,hi=lane>>5; const int wid=__builtin_amdgcn_readfirstlane(tid>>6);
  const long rowbase=(long)b*SEQ; const int q0=qb*QB;
  const bf16*Qw=Q+(rowbase+q0+wid*QBLK)*DM+h*D;
  const bf16*Kh=K+rowbase*DM+h*D,*Vh=V+rowbase*DM+h*D;
  const unsigned lds0=(unsigned)(uintptr_t)shm;
  float*wsf=(float*)(shm+LDS_WS)+wid*64;
  const bf16*ksrc=Kh+(long)lane*DM+wid*8;
  const bf16*vsrc=Vh+(long)(16*(wid&3)+(lane>>2))*DM+(wid>>2)*32+(lane&3)*8;
  const unsigned kdst=lds0+LDS_K+wid*1024, vdst=lds0+LDS_V+wid*1024;
  #define DMA_K(t,slot) glds16(ksrc+(long)(t)*KVBLK*DM,(unsigned)__builtin_amdgcn_readfirstlane(kdst+(slot)))
  #define DMA_V(t,slot) glds16(vsrc+(long)(t)*KVBLK*DM,(unsigned)__builtin_amdgcn_readfirstlane(vdst+(slot)))
  const int vb0=(int)(lds0+LDS_V)+((lane>>4)&1)*32+(lane&3)*8+(4*hi+((lane&15)>>2))*64;
  const char*Kbase=shm+LDS_K; bf16x8 kf[8];
  const lds_cptr shm3=(lds_cptr)shm; const lds_cptr kp0=shm3+LDS_K+hi*1024+r32*16; const lds_cptr vp0=shm3+LDS_V+((lane>>4)&1)*32+(lane&3)*8+(4*hi+((lane&15)>>2))*64;
  const int NT=(q0+QB)/KVBLK;
  const lds_cptr tab3=(lds_cptr)shm+LDS_TAB;
  { int tq_=tid; asm volatile("":"+v"(tq_)); __attribute__((address_space(3))) float* tabw=(__attribute__((address_space(3))) float*)((__attribute__((address_space(3))) char*)shm+LDS_TAB);
    if(MODE==0){ const f32x4_t kv=*reinterpret_cast<const f32x4_t*>(X.kbias+tq_*4); *reinterpret_cast<__attribute__((address_space(3))) f32x4_t*>(tabw+tq_*4)=kv; }
    else{ const int hm=h-8; { const int j=tq_>>6,d=tq_&63; const float*kp=X.kpart+(long)((b*8+j)*2)*512+hm*64+d; tabw[j*64+d]=(kp[0]+kp[512])*(1.0f/256.0f); }
      { const int tv=tq_; const int n=tv-256; float val=0.f;
        if(n>=0&&n<113){ int bk=n; if(n>=16){ bk=16+(n>=19)+(n>=21)+(n>=24)+(n>=27)+(n>=31)+(n>=35)+(n>=40)+(n>=46)+(n>=52)+(n>=59)+(n>=67)+(n>=77)+(n>=87)+(n>=99); }
          val=(X.relb[bk*8+hm]-X.relb[31*8+hm])*1.4426950408889634f; }
        tabw[512+tv]=val; } } }
  DMA_K(0,0);DMA_V(0,0);DMA_K(1,SLOTB);
  bf16x8 qr[4];
  { int lq_=lane; asm volatile("":"+v"(lq_)); const int rq_=lq_&31,hq_=lq_>>5;
  #pragma unroll
  for(int d0=0;d0<4;++d0)qr[d0]=*reinterpret_cast<const bf16x8*>(&Qw[(long)rq_*DM+d0*16+hq_*8]); }
  float mhat=0.f,l_reg=0.f;f32x16 o[2];o[0]=f32x16{};o[1]=f32x16{};
  const int qrel=wid*QBLK+r32;
  unsigned selmask=0u;
  #define CINIT(C0,C1,t) do{ const int t_=(t); \
    if(MODE==0){ const lds_cptr kbp_=tab3+(64*t_+4*hi)*4; \
      _Pragma("unroll") for(int j_=0;j_<4;++j_){ const f32x4_t a_=*(const __attribute__((address_space(3))) f32x4_t*)(kbp_+32*j_); const f32x4_t b_=*(const __attribute__((address_space(3))) f32x4_t*)(kbp_+128+32*j_); \
        _Pragma("unroll") for(int i_=0;i_<4;++i_){ C0[4*j_+i_]=a_[i_]-mhat; C1[4*j_+i_]=b_[i_]-mhat; } } } \
    else{ const int blk_=t_>>2; const bool keep_=(blk_>=qb)||(((selmask>>blk_)&1u)!=0u); const float c_=keep_?-mhat:-INFINITY; \
      _Pragma("unroll") for(int r_=0;r_<16;++r_){C0[r_]=c_;C1[r_]=c_;} } }while(0)
  #define TMASK(P0,P1,t) do{ const int t_=(t); \
    if(MODE==1){ \
      if(64*t_+176>q0+32*wid){ const int db_=(q0-64*t_)+qrel-4*hi; \
        const lds_cptr tbp_=tab3+2048+4*(db_+256-63); \
        _Pragma("unroll") for(int r_=0;r_<16;++r_){ const int ko_=(r_&3)+8*(r_>>2); \
          P0[r_]+=*(const __attribute__((address_space(3))) float*)(tbp_+4*(63-ko_)); P1[r_]+=*(const __attribute__((address_space(3))) float*)(tbp_+4*(31-ko_)); } } } \
    { const int jb_=t_-(NT-4); if(jb_>=0)cmask(P0,P1,jb_,qrel,hi); } }while(0)
  #define CMASK(P0,P1,t) TMASK(P0,P1,t)
  bool resc=false;
  #define START(P0,P1) do{ const float rm=rowmax(P0,P1); resc=false; \
    { const float dl=(rm>-INFINITY)?rm:0.f; mhat=fadd_s(mhat,dl); \
      _Pragma("unroll") for(int r=0;r<16;++r){P0[r]=fsub_s(P0[r],dl);P1[r]=fsub_s(P1[r],dl);} \
    } \
    _Pragma("unroll") for(int r=0;r<16;++r)P0[r]=__builtin_amdgcn_exp2f(P0[r]); }while(0)
  #define RESC() do{ if(resc){ asm volatile("s_waitcnt lgkmcnt(0)":::"memory"); \
      _Pragma("unroll") for(int d_=0;d_<2;++d_) _Pragma("unroll") for(int r=0;r<16;++r)o[d_][r]*=wsf[crow(r,hi)]; } }while(0)
  f32x16 pA0,pA1,pB0,pB1;
  int sl_prev=0,sl_cur=0,sl_next=SLOTB;
  #define ROT() do{sl_prev=sl_cur;sl_cur=sl_next;sl_next=(sl_next==(NSLOT-1)*SLOTB)?0:sl_next+SLOTB;}while(0)
  DMA_K(2,2*SLOTB);
  WAIT_BAR(3);
  if(MODE==1){
    float gt[7];
    #pragma unroll
    for(int j=0;j<7;++j){ float s=0.f;
      #pragma unroll
      for(int d0=0;d0<4;++d0){ const f32x4_t ka=*(const __attribute__((address_space(3))) f32x4_t*)(tab3+(j*64+16*d0+8*hi)*4); const f32x4_t kb2=*(const __attribute__((address_space(3))) f32x4_t*)(tab3+(j*64+16*d0+8*hi+4)*4);
        #pragma unroll
        for(int i=0;i<4;++i){ s+=__uint_as_float(((unsigned)(unsigned short)qr[d0][i])<<16)*ka[i]; s+=__uint_as_float(((unsigned)(unsigned short)qr[d0][4+i])<<16)*kb2[i]; } }
      auto rr=__builtin_amdgcn_permlane32_swap(__float_as_uint(s),__float_as_uint(s),false,false); s=__uint_as_float(rr[0])+__uint_as_float(rr[1]);
      gt[j]=(j<qb)?s:-INFINITY; }
    #pragma unroll
    for(int j=0;j<7;++j){ int rk=0;
      #pragma unroll
      for(int k=0;k<7;++k){ if(k!=j){ rk+=(gt[k]>gt[j]||(gt[k]==gt[j]&&k<j))?1:0; } }
      if(j<qb&&rk<3)selmask|=(1u<<j); } }
  CINIT(pA0,pA1,0); qkt(pA0,pA1,Kbase,qr,r32,hi);asm volatile("s_nop 15\n\ts_nop 7":"+v"(pA0),"+v"(pA1));CMASK(pA0,pA1,0);
  START(pA0,pA1);
  _Pragma("unroll") for(int r=0;r<16;++r)pA1[r]=__builtin_amdgcn_exp2f(pA1[r]);
  WAIT_BAR(0);
  DMA_K(3,0);DMA_V(1,SLOTB);
  ROT();
  kload8(kf,kp0+sl_cur);
  WAIT_BAR(2);
  s16x4 vlo[8],vhi[8]; u32x4 pw0,pw1,pw2,pw3;
  #define PKW(P,B) cvtpk_s(P[B],P[B+1])
  #define PAF(k) __builtin_bit_cast(bf16x8,pw##k)
  #define VFR(i) (bf16x8){vlo[i][0],vlo[i][1],vlo[i][2],vlo[i][3],vhi[i][0],vhi[i][1],vhi[i][2],vhi[i][3]}
  #define PIN(x) asm volatile("":"+v"(x))
  #define MX3(a,b,c) __builtin_fmaxf(__builtin_fmaxf((a),(b)),(c))
  #define GAPA(MF,A0,A1,A2,A3,W0,W1,PW) do{ MF; sacc+=A0; sacc+=A1; sacc+=A2; sacc+=A3; PIN(sacc); W0; W1; PIN(PW); SBAR(); }while(0)
  #define EX(v) __builtin_amdgcn_exp2f(v)
  #define GAPB(MF,X,B) do{ MF; X[B]=EX(X[B]); X[B+1]=EX(X[B+1]); X[B+2]=EX(X[B+2]); X[B+3]=EX(X[B+3]); PIN(X); SBAR(); }while(0)
  #define VRD(i) do{ vlo[i]=vtr(vp_+(((i)>>2)*4096+((i)&3)*1024)); vhi[i]=vtr(vp_+(((i)>>2)*4096+((i)&3)*1024+512)); }while(0)
  #define KRD(G,j) do{ if(G){ kload2(kf,kp0+sl_next,j); SBAR(); } }while(0)
  #define STEP(C0,C1,P0,P1,t,GK,GV,GL) do{ SBAR(); CINIT(C0,C1,t); SBAR(); \
    const lds_cptr vp_=vp0+sl_prev; \
    VRD(0); SBAR(); float sacc=(P0[0]+P0[1]); \
    GAPA(C0=__builtin_amdgcn_mfma_f32_32x32x16_bf16(kf[0],qr[0],C0,0,0,0), P0[2],P0[3],P0[4],P0[5],     pw0[0]=PKW(P0,0), pw0[1]=PKW(P0,2), pw0); \
    VRD(4); SBAR(); GAPA(C1=__builtin_amdgcn_mfma_f32_32x32x16_bf16(kf[1],qr[0],C1,0,0,0), P0[6],P0[7],P0[8],P0[9],     pw0[2]=PKW(P0,4), pw0[3]=PKW(P0,6), pw0); \
    VRD(1); SBAR(); GAPA(C0=__builtin_amdgcn_mfma_f32_32x32x16_bf16(kf[2],qr[1],C0,0,0,0),   P0[10],P0[11],P0[12],P0[13], pw1[0]=PKW(P0,8), pw1[1]=PKW(P0,10), pw1); \
    VRD(5); SBAR(); GAPA(C1=__builtin_amdgcn_mfma_f32_32x32x16_bf16(kf[3],qr[1],C1,0,0,0),   P0[14],P0[15],P1[0],P1[1],   pw1[2]=PKW(P0,12),pw1[3]=PKW(P0,14), pw1); \
    VRD(2); SBAR(); GAPA(C0=__builtin_amdgcn_mfma_f32_32x32x16_bf16(kf[4],qr[2],C0,0,0,0),   P1[2],P1[3],P1[4],P1[5],     pw2[0]=PKW(P1,0), pw2[1]=PKW(P1,2), pw2); \
    VRD(6); SBAR(); GAPA(C1=__builtin_amdgcn_mfma_f32_32x32x16_bf16(kf[5],qr[2],C1,0,0,0),   P1[6],P1[7],P1[8],P1[9],     pw2[2]=PKW(P1,4), pw2[3]=PKW(P1,6), pw2); \
    VRD(3); SBAR(); GAPA(C0=__builtin_amdgcn_mfma_f32_32x32x16_bf16(kf[6],qr[3],C0,0,0,0),   P1[10],P1[11],P1[12],P1[13], pw3[0]=PKW(P1,8), pw3[1]=PKW(P1,10), pw3); \
    VRD(7); SBAR(); GAPA(C1=__builtin_amdgcn_mfma_f32_32x32x16_bf16(kf[7],qr[3],C1,0,0,0),   P1[14],P1[15],0.f,0.f,       pw3[2]=PKW(P1,12),pw3[3]=PKW(P1,14), pw3); \
    l_reg+=sacc; \
    if(GK){DMA_K((t)+3,sl_cur);} if(GV){DMA_V((t)+1,sl_next);} \
    CMASK(C0,C1,t); \
    { float a=MX3(C0[0],C0[1],C1[0]),b=MX3(C0[2],C0[3],C1[1]); a=MX3(a,C1[2],C1[3]); \
      _Pragma("unroll") for(int r=4;r<16;r+=4){a=MX3(a,C0[r],C0[r+1]);b=MX3(b,C0[r+2],C0[r+3]);a=MX3(a,C1[r],C1[r+1]);b=MX3(b,C1[r+2],C1[r+3]);} \
      float rm=__builtin_fmaxf(a,b); { auto rr=__builtin_amdgcn_permlane32_swap(__float_as_uint(rm),__float_as_uint(rm),false,false); rm=__builtin_fmaxf(__uint_as_float(rr[0]),__uint_as_float(rr[1])); } \
      resc=false; \
      if(__builtin_expect(__any(rm>(float)THRL),0)){ const float dl=__builtin_fmaxf(rm,0.f); mhat+=dl; \
        _Pragma("unroll") for(int r=0;r<16;++r){C0[r]-=dl;C1[r]-=dl;} \
        const float f=__builtin_amdgcn_exp2f(-dl); l_reg*=f; if(hi==0)wsf[r32]=f; resc=true; } } \
    SBAR(); \
    GAPB(o[0]=__builtin_amdgcn_mfma_f32_32x32x16_bf16(PAF(0),VFR(0),o[0],0,0,0), C0,0); \
    GAPB(o[1]=__builtin_amdgcn_mfma_f32_32x32x16_bf16(PAF(0),VFR(4),o[1],0,0,0), C0,4); \
    KRD(GL,0); GAPB(o[0]=__builtin_amdgcn_mfma_f32_32x32x16_bf16(PAF(1),VFR(1),o[0],0,0,0), C0,8); \
    KRD(GL,1); GAPB(o[1]=__builtin_amdgcn_mfma_f32_32x32x16_bf16(PAF(1),VFR(5),o[1],0,0,0), C0,12); \
    KRD(GL,2); GAPB(o[0]=__builtin_amdgcn_mfma_f32_32x32x16_bf16(PAF(2),VFR(2),o[0],0,0,0), C1,0); \
    KRD(GL,3); GAPB(o[1]=__builtin_amdgcn_mfma_f32_32x32x16_bf16(PAF(2),VFR(6),o[1],0,0,0), C1,4); \
    GAPB(o[0]=__builtin_amdgcn_mfma_f32_32x32x16_bf16(PAF(3),VFR(3),o[0],0,0,0), C1,8); \
    GAPB(o[1]=__builtin_amdgcn_mfma_f32_32x32x16_bf16(PAF(3),VFR(7),o[1],0,0,0), C1,12); \
    }while(0)
  int t=1;
  for(;t+5<NT;t+=2){
    STEP(pB0,pB1,pA0,pA1,t,true,true,true);     WAIT_BAR(2); RESC(); ROT();
    STEP(pA0,pA1,pB0,pB1,t+1,true,true,true);   WAIT_BAR(2); RESC(); ROT();
  }
  #define ENDW(tt) do{ if((tt)+3<NT){WAIT_BAR(2);} else if((tt)+2<NT){WAIT_BAR(1);} else {WAIT_BAR(0);} }while(0)
  for(;t+1<NT;t+=2){
    STEP(pB0,pB1,pA0,pA1,t,(t+3<NT),(t+1<NT),(t+1<NT));       ENDW(t);   RESC(); ROT();
    STEP(pA0,pA1,pB0,pB1,t+1,(t+4<NT),(t+2<NT),(t+2<NT));     ENDW(t+1); RESC(); ROT();
  }
  STEP(pB0,pB1,pA0,pA1,NT-1,false,false,false); RESC();
  { float sacc=pB0[0]+pB0[1]; _Pragma("unroll") for(int r=2;r<16;++r)sacc+=pB0[r]; _Pragma("unroll") for(int r=0;r<16;++r)sacc+=pB1[r]; l_reg+=sacc;
    pw0=(u32x4){PKW(pB0,0),PKW(pB0,2),PKW(pB0,4),PKW(pB0,6)};pw1=(u32x4){PKW(pB0,8),PKW(pB0,10),PKW(pB0,12),PKW(pB0,14)};pw2=(u32x4){PKW(pB1,0),PKW(pB1,2),PKW(pB1,4),PKW(pB1,6)};pw3=(u32x4){PKW(pB1,8),PKW(pB1,10),PKW(pB1,12),PKW(pB1,14)};
    SBAR(); pv(o,vb0+sl_cur,PAF(0),PAF(1),PAF(2),PAF(3)); }
  #undef PKW
  #undef PAF
  #undef VFR
  #undef PIN
  #undef MX3
  #undef GAPA
  #undef GAPB
  #undef EX
  #undef VRD
  #undef KRD
  #undef STEP
  #undef ENDW
  {auto rr=__builtin_amdgcn_permlane32_swap(__float_as_uint(l_reg),__float_as_uint(l_reg),false,false);l_reg=__uint_as_float(rr[0])+__uint_as_float(rr[1]);}
  if(hi==0)wsf[32+r32]=l_reg;asm volatile("s_waitcnt lgkmcnt(0)":::"memory");
  float rli[16];
  #pragma unroll
  for(int r=0;r<16;++r)rli[r]=__builtin_amdgcn_rcpf(wsf[32+crow(r,hi)]);
  bf16*Ow=O+(rowbase+q0+wid*QBLK)*DM+h*D;
  { bf16*stg=(bf16*)(shm+LDS_OST)+wid*2048;
    #pragma unroll
    for(int r=0;r<16;++r){const int orow=crow(r,hi);
      #pragma unroll
      for(int d0=0;d0<2;++d0)stg[orow*64+d0*32+r32]=__float2bfloat16(o[d0][r]*rli[r]);}
    asm volatile("s_waitcnt lgkmcnt(0)":::"memory");
    int lv_=lane; asm volatile("":"+v"(lv_));
    #pragma unroll
    for(int i=0;i<4;++i){const int row=i*8+(lv_>>3),ch=lv_&7; const u32x4 v=*(const u32x4*)(stg+row*64+ch*8); ATTN_STORE16(Ow+(long)row*DM+ch*8,v);} }
  asm volatile("s_waitcnt lgkmcnt(0)\n\ts_barrier":::"memory");
  #undef DMA_K
  #undef DMA_V
  #undef CMASK
  #undef TMASK
  #undef CINIT
  #undef START
  #undef RESC
  #undef ROT
}
constexpr int ATTN_LDS_BYTES=LDS_BYTES;
struct AttnTensors { const bf16* Q; const bf16* K; const bf16* V; bf16* O; };
struct AttnUnit { int b, h, qb; };
struct StaticOrder {
  int vcu, G;
  __device__ __forceinline__ explicit StaticOrder(int grid,int vcu_):vcu(vcu_),G(grid){}
  __device__ __forceinline__ bool next(int i,AttnUnit&u)const{ const int L=i*G+vcu; if(L>=2048)return false; const int v=L&255,k=L>>8,s=v>>1; const int moba=(k>>2)&1; const int setA=((v&1)^moba);
    const int kk=k&3; const int qa=(kk==0)?0:(kk==1)?3:(kk==2)?4:7, qb2=(kk==0)?1:(kk==1)?2:(kk==2)?5:6;
    u.b=s>>3; u.h=(s&7)+8*moba; u.qb=setA?qb2:qa; return true; }
};
template<class Sched,int THRL=8> __device__ __forceinline__ void attn_phase(int tid,char*lds,const AttnTensors&T,const Sched&S,const float*kbias,const float*kpart,const float*relb){
  AttnUnit u;
  for(int i=0;S.next(i,u);++i){ AttnExtra X; X.kbias=kbias+(long)(u.b*8+(u.h&7))*SEQ; X.kpart=kpart; X.relb=relb;
#if !defined(ATT_ONLY) || ATT_ONLY==0
    if(u.h<8) attn_unit<THRL,0>(u.b,u.h,u.qb,T.Q,T.K,T.V,T.O,lds,X,tid);
#endif
#if !defined(ATT_ONLY) || ATT_ONLY==1
    if(u.h>=8) attn_unit<THRL,1>(u.b,u.h,u.qb,T.Q,T.K,T.V,T.O,lds,X,tid);
#endif
  }
}
#undef SBAR
#undef WAIT_BAR
}
#define XB_TMO      128
#define XB_XCNT(j)  (256  + 64 * (j))
#define XB_XSUB(j)  (1280 + 64 * (j))
#define XB_XGEN(j)  (2304 + 64 * (j))
#define XB_TOP      3328
#define XB_TOPGEN   3392
#define XCD_BAR_WORDS 3456
#define XB_SPIN_CAP (1u << 18)

__device__ __forceinline__ unsigned xb_ld(unsigned* p)              { return __hip_atomic_load(p, __ATOMIC_RELAXED, __HIP_MEMORY_SCOPE_AGENT); }
__device__ __forceinline__ unsigned xb_add(unsigned* p, unsigned v) { return __hip_atomic_fetch_add(p, v, __ATOMIC_RELAXED, __HIP_MEMORY_SCOPE_AGENT); }
__device__ __forceinline__ unsigned xb_xcc_id() { return (unsigned)__builtin_amdgcn_s_getreg((3 << 11) | 20) & 0xFu; }
#define XB_SPIN(cond, bar) do { unsigned _sp = 0; while (cond) { __builtin_amdgcn_s_sleep(1); \
    if ((++_sp & 255u) == 0u) { if (xb_ld(&(bar)[XB_TMO])) break; if (_sp > XB_SPIN_CAP) { atomicAdd(&(bar)[XB_TMO], 1u); break; } } } } while (0)

struct XcdBarrier {
    unsigned* bar; unsigned x;
    volatile LAS unsigned* st;
};

__device__ __forceinline__ XcdBarrier xcd_barrier_post(unsigned* bar, volatile LAS unsigned* st) {
    XcdBarrier b; b.bar = bar; b.x = xb_xcc_id(); b.st = st;
    if (threadIdx.x == 0) (void)xb_add(&bar[XB_XCNT(b.x)], 1u);
    return b;
}
__device__ __forceinline__ void xcd_barrier_complete(unsigned* bar, unsigned x, unsigned& nloc, unsigned& nx) {
    const unsigned G = gridDim.x * gridDim.y * gridDim.z;
    unsigned sum, cnt, mine, sp = 0u;
    for (;;) {
        sum = 0u; cnt = 0u; mine = 0u;
#pragma unroll
        for (unsigned j = 0; j < 16; ++j) { const unsigned c = xb_ld(&bar[XB_XCNT(j)]); sum += c; cnt += (c > 0u) ? 1u : 0u; mine = (j == x) ? c : mine; }
        if (sum == G) break;
        __builtin_amdgcn_s_sleep(1);
        if ((++sp & 255u) == 0u) { if (xb_ld(&bar[XB_TMO])) break; if (sp > XB_SPIN_CAP) { atomicAdd(&bar[XB_TMO], 1u); break; } }
    }
    nloc = mine > 0u ? mine : 1u; nx = cnt > 0u ? cnt : 1u;
}

__device__ __forceinline__ void xcd_barrier(const XcdBarrier& b) {
    asm volatile("s_waitcnt vmcnt(0)" ::: "memory");
    __syncthreads();
    if (threadIdx.x == 0) {
        unsigned* bar = b.bar;
        __builtin_amdgcn_s_waitcnt(0);
        unsigned nloc = b.st[0], nx = b.st[1];
        if (nloc == 0u) { xcd_barrier_complete(bar, b.x, nloc, nx); b.st[0] = nloc; b.st[1] = nx; }
        const unsigned old = xb_add(&bar[XB_XSUB(b.x)], 1u);
        const unsigned gen = old / nloc;
        if (old + 1u == (gen + 1u) * nloc) {
            __builtin_amdgcn_fence(__ATOMIC_RELEASE, "agent");
            asm volatile("s_waitcnt vmcnt(0)" ::: "memory");
            const unsigned og = xb_add(&bar[XB_TOP], 1u);
            const unsigned tg = og / nx;
            if (og + 1u == (tg + 1u) * nx) xb_add(&bar[XB_TOPGEN], 1u);
            else XB_SPIN(xb_ld(&bar[XB_TOPGEN]) == tg, bar);
            __builtin_amdgcn_fence(__ATOMIC_ACQUIRE, "agent");
            xb_add(&bar[XB_XGEN(b.x)], 1u);
            asm volatile("s_waitcnt vmcnt(0)" ::: "memory");
        } else {
            XB_SPIN(xb_ld(&bar[XB_XGEN(b.x)]) == gen, bar);
            __builtin_amdgcn_fence(__ATOMIC_ACQUIRE, "agent");
            asm volatile("s_waitcnt vmcnt(0)" ::: "memory");
        }
    }
    __syncthreads();
}
constexpr int NWAVES = 8;
#define LDS_WAIT() asm volatile("s_waitcnt lgkmcnt(0)" ::: "memory")
#define VM_WAIT() asm volatile("s_waitcnt vmcnt(0)" ::: "memory")
__device__ __forceinline__ float wave_sum(float v) {
#pragma unroll
    for (int o = 1; o < 64; o <<= 1) v += __shfl_xor(v, o);
    return v;
}
__device__ __forceinline__ void row_load(const float* p, int lane, f32x4 (&v)[4]) {
    const GAS f32x4* xr = (const GAS f32x4*)p + lane;
#pragma unroll
    for (int j = 0; j < 4; ++j) v[j] = xr[64 * j];
}
__device__ __forceinline__ void row_store_f32(float* p, int lane, const f32x4 (&v)[4]) {
    GAS f32x4* o = (GAS f32x4*)p + lane;
#pragma unroll
    for (int j = 0; j < 4; ++j) o[64 * j] = v[j];
}
__device__ __forceinline__ void row_store_bf16(bf16_t* p, int lane, const f32x4 (&v)[4]) {
    GAS u32x2* o = (GAS u32x2*)p + lane;
#pragma unroll
    for (int j = 0; j < 4; ++j) { u32x2 w; w.x = cvt_pk_bf16(v[j][0], v[j][1]); w.y = cvt_pk_bf16(v[j][2], v[j][3]); o[64 * j] = w; }
}
__device__ __forceinline__ void row_layernorm(f32x4 (&v)[4], const f32x4 (&g)[4], const f32x4 (&b)[4]) {
    float s = 0.f;
#pragma unroll
    for (int j = 0; j < 4; ++j) s += (v[j][0] + v[j][1]) + (v[j][2] + v[j][3]);
    const float mean = wave_sum(s) * (1.f / DM); float s2 = 0.f;
#pragma unroll
    for (int j = 0; j < 4; ++j) { v[j] = v[j] - mean; s2 += (v[j][0] * v[j][0] + v[j][1] * v[j][1]) + (v[j][2] * v[j][2] + v[j][3] * v[j][3]); }
    const float rstd = 1.f / sqrtf(wave_sum(s2) * (1.f / DM) + LN_EPS);
#pragma unroll
    for (int j = 0; j < 4; ++j) v[j] = v[j] * rstd * g[j] + b[j];
}
template <int H, int MASK, int N> __device__ __forceinline__ void bfly_step(float (&v)[N], int lane) {
    const bool up = (lane & MASK) != 0;
#pragma unroll
    for (int i = 0; i < H; ++i) { const float a = v[i], b = v[i + H]; const float send = up ? a : b, keep = up ? b : a; v[i] = keep + __shfl_xor(send, MASK); }
}
__device__ __forceinline__ void butterfly64(float (&v)[64], int lane) { bfly_step<32, 32>(v, lane); bfly_step<16, 16>(v, lane); bfly_step<8, 8>(v, lane); bfly_step<4, 4>(v, lane); bfly_step<2, 2>(v, lane); bfly_step<1, 1>(v, lane); }
__device__ __forceinline__ void butterfly32(float (&v)[32], int lane) { bfly_step<16, 32>(v, lane); bfly_step<8, 16>(v, lane); bfly_step<4, 8>(v, lane); bfly_step<2, 4>(v, lane); bfly_step<1, 2>(v, lane); v[0] += __shfl_xor(v[0], 1); }
template <int E> __device__ __forceinline__ void thin_dot(const f32x4 (&xn)[4][4], const LAS float* w, int ws, int lane, float (&acc)[4 * E]) {
#pragma unroll
    for (int i = 0; i < 4 * E; ++i) acc[i] = 0.f;
#pragma unroll
    for (int e = 0; e < E; ++e)
#pragma unroll
        for (int j = 0; j < 4; ++j) { const f32x4 wv = *(const LAS f32x4*)(w + e * ws + 4 * lane + 256 * j);
#pragma unroll
            for (int r = 0; r < 4; ++r) { float a = acc[r * E + e]; a = fmaf(xn[r][j][0], wv[0], a); a = fmaf(xn[r][j][1], wv[1], a); a = fmaf(xn[r][j][2], wv[2], a); a = fmaf(xn[r][j][3], wv[3], a); acc[r * E + e] = a; } }
}
__device__ __forceinline__ float log_sigmoid(float z) { const float a = fabsf(z); return fminf(z, 0.f) - log1pf(__expf(-a)); }

__device__ __forceinline__ void forget_rows(const f32x4 (&xn)[4][4], const LAS float* wf, const float* bf, float* logf, int t0, int lane) {
    float acc[32]; thin_dot<8>(xn, wf, 1024, lane, acc); butterfly32(acc, lane);
    const int r = lane >> 4, h = (lane >> 1) & 7, t = t0 + r;
    if ((lane & 1) == 0) logf[(size_t)((t >> 11) * 8 + h) * SEQ + (t & (SEQ - 1))] = log_sigmoid(acc[0] + bf[h]);
}
__device__ __forceinline__ void load_wf(const float* w_in_l, LAS float* wf, int tid) {
    for (int idx = tid; idx < 8192; idx += NWAVES * 64) { const int k = idx >> 3, h = idx & 7; wf[h * 1024 + k] = w_in_l[(size_t)k * IN_COLS + FCOL + h]; }
}

template <int MAPK> __device__ __forceinline__ int wt_map(int n) {
    if (MAPK == 0) return n;
    if (MAPK == 1) return n < FCOL ? n : (n < FCOL + 8 ? -1 : n - 8);
    return ((n & 1023) >> 7) * 256 + (n >> 10) * 128 + (n & 127);
}
constexpr int TR_TILE_BYTES = 64 * 65 * 4;
template <int MAPK> __device__ __forceinline__ void transpose_item(const float* W, int K, int N, bf16_t* WT, LAS float* scr, int item, int lane) {
    const int nblk = (N + 63) / 64, kb = item / nblk, nb = item % nblk, k0 = 64 * kb, n0 = 64 * nb;
    const int n4 = (lane & 15) * 4, kr = lane >> 4;
    const bool ok = (n0 + n4) < N;
    const GAS f32x4* src = (const GAS f32x4*)(W + (size_t)(k0 + kr) * N + n0 + n4);
    f32x4 v[16];
#pragma unroll
    for (int i = 0; i < 16; ++i) v[i] = ok ? src[(size_t)i * N] : (f32x4){0.f, 0.f, 0.f, 0.f};
#pragma unroll
    for (int i = 0; i < 16; ++i) { const int k = 4 * i + kr; scr[(n4 + 0) * 65 + k] = v[i][0]; scr[(n4 + 1) * 65 + k] = v[i][1]; scr[(n4 + 2) * 65 + k] = v[i][2]; scr[(n4 + 3) * 65 + k] = v[i][3]; }
    LDS_WAIT(); asm volatile("" ::: "memory");
    const int c = lane & 7;
#pragma unroll
    for (int j = 0; j < 8; ++j) { const int nl = (lane >> 3) + 8 * j, n = n0 + nl; const int dr = wt_map<MAPK>(n); const LAS float* s = scr + nl * 65 + 8 * c;
        u32x4 o; o.x = cvt_pk_bf16(s[0], s[1]); o.y = cvt_pk_bf16(s[2], s[3]); o.z = cvt_pk_bf16(s[4], s[5]); o.w = cvt_pk_bf16(s[6], s[7]);
        if (n < N && dr >= 0) *(GAS u32x4*)(WT + (size_t)dr * K + k0 + 8 * c) = o; }
    LDS_WAIT(); asm volatile("" ::: "memory");
}
constexpr size_t MiB = 1u << 20;
constexpr size_t WS_CTL = 0, CTL_ZERO_BYTES = 1 * MiB;
constexpr size_t WS_WIN = 2 * MiB, WS_WO = 26 * MiB, WS_WCQ = 34 * MiB, WS_WCK = 42 * MiB, WS_WCV = 50 * MiB, WS_WCO = 58 * MiB;
constexpr size_t WS_WGU = 66 * MiB, WS_WD = 578 * MiB;
constexpr size_t WS_XB = 834 * MiB, WS_Q = 898 * MiB, WS_K = 962 * MiB, WS_V = 1026 * MiB;
constexpr size_t WS_MEMB = 1090 * MiB, WS_KC = 1098 * MiB, WS_VT = 1130 * MiB;
constexpr size_t WS_LOGF = 1162 * MiB, WS_KB = 1163 * MiB, WS_KPART = 1164 * MiB;
constexpr size_t WS_ASGE = 1165 * MiB, WS_ASGR = WS_ASGE + 512 * 1024, WS_ASGG = 1166 * MiB;
constexpr size_t WS_STOK = 1167 * MiB;
constexpr size_t WS_ACT = 1171 * MiB, WS_YEXP = 1443 * MiB, WS_END = 1715 * MiB;
static_assert(WS_ACT + (size_t)MAXTILES * 256 * DM * 2 <= WS_YEXP && WS_YEXP + (size_t)MAXTILES * 256 * DM * 2 <= WS_END, "d_ws map");
constexpr int CW_TMO = 0, CW_CODE = 1;
constexpr int CW_BAR = 4096;
constexpr int CW_CNT = 16384;
static_assert((CW_CNT + NL * NE * 64) * 4 <= (int)CTL_ZERO_BYTES && CW_BAR + XCD_BAR_WORDS <= CW_CNT, "CTL words inside the memset region");
constexpr int RING_OFF = 0, RING_BYTES = 131072;
constexpr int XCH_OFF = RING_BYTES;
constexpr int MOE_OFF = XCH_OFF + 8192;
constexpr int ARGT_OFF = MOE_OFF + 288;
constexpr int MISC_OFF = MOE_OFF + 512;
static_assert(8 * TR_TILE_BYTES <= MOE_OFF, "prologue transpose tiles");
constexpr int LDS_BYTES = 147456;
static_assert(MISC_OFF + 128 <= LDS_BYTES, "LDS map");
constexpr int NPHASE = 2 + 12 * NL;

struct Args { const float* in[22]; float* out; unsigned char* ws; int ph_lo, ph_hi; };

struct KVOrder {
    int G, c;
    __device__ __forceinline__ bool next(int i, pg8::Unit& u) const {
        const long L = (long)i * G + c; if (L >= 512) return false;
        const int wgid = pg8::xcd_chunk((int)L, 512), l = wgid >> 7, r = wgid & 127, kind = r >> 6, rr = r & 63;
        const int pm = kind ? (rr & 3) : (rr & 15), pn = kind ? (rr >> 2) : (rr >> 4);
        u.abyte = (long)(kind ? WS_WCV + (size_t)l * 2 * MiB : WS_MEMB) + (long)pm * 256 * DM * 2;
        u.bbyte = (long)(kind ? WS_MEMB : WS_WCK + (size_t)l * 2 * MiB) + (long)pn * 256 * DM * 2;
        u.orow = pm * 256; u.ocol = pn * 256; u.aux = l * 2 + kind; u.grow = 0; u.gcnt = 256; return true;
    }
};
struct EpiKV {
    static constexpr bool PERM = true;
    bf16_t* KC; bf16_t* VT;
    __device__ __forceinline__ void operator()(const f32x4 (&acc)[2][2][4][2], const pg8::Unit& u, const pg8::EpiCtx& c) const {
        const int l = u.aux >> 1, kind = u.aux & 1, ldc = kind ? TM : DM;
        bf16_t* O = (kind ? VT : KC) + (size_t)l * TM * DM;
        const int row0 = u.orow + c.wr * 64 + c.fr, col0 = u.ocol + c.wc * 32 + 8 * c.fq;
#pragma unroll
        for (int ai = 0; ai < 2; ++ai)
#pragma unroll
            for (int m = 0; m < 4; ++m) { bf16_t* rowp = O + (size_t)(row0 + ai * 128 + m * 16) * ldc + col0;
#pragma unroll
                for (int bj = 0; bj < 2; ++bj) { const f32x4 v0 = acc[ai][bj][m][0], v1 = acc[ai][bj][m][1];
                    u32x4 w; w.x = cvt_pk_bf16(v0[0], v0[1]); w.y = cvt_pk_bf16(v0[2], v0[3]); w.z = cvt_pk_bf16(v1[0], v1[1]); w.w = cvt_pk_bf16(v1[2], v1[3]);
                    *(u32x4*)(rowp + bj * 128) = w; } }
    }
};

#define PHASE_TID() int lane_; asm volatile("v_mbcnt_lo_u32_b32 %0, -1, 0\n\tv_mbcnt_hi_u32_b32 %0, -1, %0" : "=v"(lane_)); const int lane = lane_; const int wave = wave0; const int ptid = wave * 64 + lane; (void)lane; (void)wave; (void)ptid
__device__ __forceinline__ const float* argp(const LAS unsigned long long* tab, int i) {
    const unsigned long long v = tab[i]; const unsigned lo = __builtin_amdgcn_readfirstlane((unsigned)v), hi = __builtin_amdgcn_readfirstlane((unsigned)(v >> 32));
    return (const float*)(((unsigned long long)hi << 32) | lo);
}
__global__ void __launch_bounds__(NWAVES * 64, 2) skel_fwd(Args args) {
    extern __shared__ __attribute__((aligned(16))) unsigned char lds_raw[];
    LAS unsigned char* lds = (LAS unsigned char*)lds_raw;
    volatile LAS unsigned* MISC = (volatile LAS unsigned*)(lds + MISC_OFF);
    const int G = gridDim.x; const int bx = blockIdx.x; const int vcu = (G % 8 == 0) ? (bx % 8) * (G / 8) + bx / 8 : bx;
    const int lo = args.ph_lo, hi = args.ph_hi;
    const int wave0 = __builtin_amdgcn_readfirstlane((int)threadIdx.x >> 6);
    LAS unsigned long long* ARGT = (LAS unsigned long long*)(lds + ARGT_OFF);
    { const int tid0 = threadIdx.x;
      for (int u = tid0; u < (LDS_BYTES - XCH_OFF) / 4; u += NWAVES * 64) ((LAS unsigned*)(lds + XCH_OFF))[u] = 0u;
      __syncthreads();
      if (tid0 == 0) {
#pragma unroll
          for (int i = 0; i < 22; ++i) ARGT[i] = (unsigned long long)args.in[i];
          ARGT[22] = (unsigned long long)args.out; ARGT[23] = (unsigned long long)args.ws; }
      __syncthreads(); }
    if (hi - lo > 1) { const XcdBarrier b0 = xcd_barrier_post((unsigned*)(args.ws + WS_CTL) + CW_BAR, MISC + 8); if (threadIdx.x == 0) MISC[10] = b0.x; }
    __syncthreads();
#ifndef PHASE_MASK
#define PHASE_MASK 0xFFFF
#endif
#define PH_ON(kind) (((PHASE_MASK) >> (kind)) & 1)
#ifndef REPEAT_MASK
#define REPEAT_MASK 0
#endif
#define REP(kind) for (int rep_ = 0; rep_ <= (((REPEAT_MASK) >> (kind)) & 1); ++rep_)
#define IN(k) (lo <= (k) && (k) < hi)
#define BOTH(k) (IN(k) && IN((k) + 1))
#define SEAM(k) do { if (BOTH(k)) { XcdBarrier b_; b_.bar = (unsigned*)WSP() + CW_BAR; b_.x = (unsigned)__builtin_amdgcn_readfirstlane((int)MISC[10]); b_.st = MISC + 8; xcd_barrier(b_); } } while (0)
#define ARGF(i) argp(ARGT, (i))
#define WSP() ((unsigned char*)ARGF(23))
    LAS int* TP = (LAS int*)(lds + MOE_OFF); LAS int* CNT = TP + 40;
    LAS unsigned char* xch = lds + XCH_OFF;
    const int NGW = G * NWAVES;

    REP(0) if (PH_ON(0) && IN(0)) {
        PHASE_TID(); unsigned char* ws = WSP(); const int gw = vcu * NWAVES + wave;
        const float* x_in = ARGF(0); const float* mem = ARGF(1); const float* w_in = ARGF(2); const float* b_forget = ARGF(3); const float* w_mix_out = ARGF(4);
        const float* w_cq = ARGF(8); const float* w_ck = ARGF(9); const float* w_cv = ARGF(10); const float* w_co = ARGF(11); const float* w_gate_up = ARGF(16); const float* w_down = ARGF(18);
        LAS float* scr = (LAS float*)(lds + RING_OFF + wave * TR_TILE_BYTES);
        constexpr int I_IN = 16 * 49, I_SQ = 16 * 16, I_GU = 16 * 32, PER_L = I_IN + 5 * I_SQ + NE * I_GU + NE * I_SQ;
        for (int it = gw; it < NL * PER_L; it += NGW) {
            const int l = it / PER_L; int r = it % PER_L;
            if (r < I_IN) { transpose_item<1>(w_in + (size_t)l * DM * IN_COLS, DM, IN_COLS, (bf16_t*)(ws + WS_WIN) + (size_t)l * IN_N * DM, scr, r, lane); continue; } r -= I_IN;
            if (r < 5 * I_SQ) { const int which = r / I_SQ, item = r % I_SQ;
                const float* W = (which == 0 ? w_mix_out : which == 1 ? w_cq : which == 2 ? w_ck : which == 3 ? w_cv : w_co) + (size_t)l * DM * DM;
                bf16_t* WT = (bf16_t*)(ws + (which == 0 ? WS_WO : which == 1 ? WS_WCQ : which == 2 ? WS_WCK : which == 3 ? WS_WCV : WS_WCO)) + (size_t)l * DM * DM;
                transpose_item<0>(W, DM, DM, WT, scr, item, lane); continue; } r -= 5 * I_SQ;
            if (r < NE * I_GU) { const int e = r / I_GU, item = r % I_GU;
                transpose_item<2>(w_gate_up + (size_t)(l * NE + e) * DM * 2048, DM, 2048, (bf16_t*)(ws + WS_WGU) + (size_t)(l * NE + e) * 2048 * DM, scr, item, lane); continue; } r -= NE * I_GU;
            { const int e = r / I_SQ, item = r % I_SQ;
                transpose_item<0>(w_down + (size_t)(l * NE + e) * DM * DM, DM, DM, (bf16_t*)(ws + WS_WD) + (size_t)(l * NE + e) * DM * DM, scr, item, lane); }
        }
        __syncthreads();
        LAS float* wf = (LAS float*)(lds + RING_OFF);
        load_wf(w_in, wf, ptid);
        __syncthreads();
        bf16_t* XB = (bf16_t*)(ws + WS_XB); float* LOGF = (float*)(ws + WS_LOGF); bf16_t* MEMB = (bf16_t*)(ws + WS_MEMB);
        for (int rg = gw; rg < T / 16; rg += NGW)
            for (int g4 = 0; g4 < 4; ++g4) { const int t0 = rg * 16 + g4 * 4; f32x4 xn[4][4];
#pragma unroll
                for (int r = 0; r < 4; ++r) { row_load(x_in + (size_t)(t0 + r) * DM, lane, xn[r]); row_store_bf16(XB + (size_t)(t0 + r) * DM, lane, xn[r]); }
                forget_rows(xn, wf, b_forget, LOGF, t0, lane); }
        for (int m = gw; m < TM; m += NGW) { f32x4 v[4]; row_load(mem + (size_t)m * DM, lane, v); row_store_bf16(MEMB + (size_t)m * DM, lane, v); }
        __syncthreads();
        SEAM(0);
    }
    REP(1) if (PH_ON(1) && IN(1)) {
        PHASE_TID(); unsigned char* ws = WSP();
        pg8::Gemm g{(const bf16_t*)ws, (const bf16_t*)ws, DM, DM, DM, nullptr}; KVOrder S{G, bx}; EpiKV E{(bf16_t*)(ws + WS_KC), (bf16_t*)(ws + WS_VT)};
        pg8::gemm_phase<EpiKV, KVOrder, false, true>(ptid, lds + RING_OFF, xch, g, S, E);
        SEAM(1);
    }
    for (int l = 0; l < NL; ++l) {
        const int pb = 2 + 12 * l;
        REP(2) if (PH_ON(2) && IN(pb + 0)) {
            PHASE_TID(); unsigned char* ws = WSP();
            { float* LOGF = (float*)(ws + WS_LOGF); float* KBIAS = (float*)(ws + WS_KB);
              for (int sq = bx; sq < NB * 8; sq += G) {
                const f32x4 v = *(const f32x4*)(LOGF + (size_t)sq * SEQ + ptid * 4);
                const float p0 = v[0], p1 = p0 + v[1], p2 = p1 + v[2], p3 = p2 + v[3];
                float inc = p3;
#pragma unroll
                for (int o = 1; o < 64; o <<= 1) { const float n = __shfl_up(inc, o); if (lane >= o) inc += n; }
                LAS float* wt = (LAS float*)xch;
                if (lane == 63) wt[wave] = inc;
                __syncthreads();
                float off = inc - p3;
                for (int w = 0; w < wave; ++w) off += wt[w];
                f32x4 o; o[0] = -(off + p0) * LOG2E; o[1] = -(off + p1) * LOG2E; o[2] = -(off + p2) * LOG2E; o[3] = -(off + p3) * LOG2E;
                *(f32x4*)(KBIAS + (size_t)sq * SEQ + ptid * 4) = o;
                __syncthreads();
              } }
            pg8::Gemm g{(const bf16_t*)(ws + WS_XB), (const bf16_t*)(ws + WS_WIN) + (size_t)l * IN_N * DM, DM, DM, DM, nullptr};
            pg8::GridOrder<0> S; S.init(T / 256, IN_N / 256, G, bx, DM, DM);
            pg8::EpiQKV E{(bf16_t*)(ws + WS_Q), (bf16_t*)(ws + WS_K), (bf16_t*)(ws + WS_V), (float*)(ws + WS_KPART)};
            pg8::gemm_phase<pg8::EpiQKV, pg8::GridOrder<0>, false, true>(ptid, lds + RING_OFF, xch, g, S, E);
            SEAM(pb + 0);
        }
        REP(3) if (PH_ON(3) && IN(pb + 1)) {
            PHASE_TID(); unsigned char* ws = WSP();
            const attn_body::AttnTensors AT{(const attn_body::bf16*)(ws + WS_Q), (const attn_body::bf16*)(ws + WS_K), (const attn_body::bf16*)(ws + WS_V), (attn_body::bf16*)(ws + WS_XB)};
            const attn_body::StaticOrder S(G, vcu);
            attn_body::attn_phase<attn_body::StaticOrder>(ptid, (char*)lds_raw + RING_OFF, AT, S, (const float*)(ws + WS_KB), (const float*)(ws + WS_KPART), ARGF(5));
            SEAM(pb + 1);
        }
        REP(4) if (PH_ON(4) && IN(pb + 2)) {
            PHASE_TID(); unsigned char* ws = WSP(); float* X = (float*)ARGF(22);
            pg8::Gemm g{(const bf16_t*)(ws + WS_XB), (const bf16_t*)(ws + WS_WO) + (size_t)l * DM * DM, DM, DM, DM, nullptr};
            pg8::GridOrder<0> S; S.init(T / 256, DM / 256, G, bx, DM, DM);
            pg8::EpiResid E{l == 0 ? ARGF(0) : (const float*)X, X};
            pg8::gemm_phase<pg8::EpiResid, pg8::GridOrder<0>, false, true>(ptid, lds + RING_OFF, xch, g, S, E);
            SEAM(pb + 2);
        }
        REP(5) if (PH_ON(5) && IN(pb + 3)) {
            PHASE_TID(); unsigned char* ws = WSP(); float* X = (float*)ARGF(22); bf16_t* XB = (bf16_t*)(ws + WS_XB); const int gw = vcu * NWAVES + wave;
            f32x4 gg[4], bb[4]; row_load(ARGF(6) + (size_t)l * DM, lane, gg); row_load(ARGF(7) + (size_t)l * DM, lane, bb);
            for (int rg = gw; rg < T / 16; rg += NGW)
                for (int r = 0; r < 16; ++r) { const size_t t = (size_t)rg * 16 + r; f32x4 v[4]; row_load(X + t * DM, lane, v); row_layernorm(v, gg, bb);
                    row_store_f32(X + t * DM, lane, v); row_store_bf16(XB + t * DM, lane, v); }
            SEAM(pb + 3);
        }
        REP(6) if (PH_ON(6) && IN(pb + 4)) {
            PHASE_TID(); unsigned char* ws = WSP();
            pg8::Gemm g{(const bf16_t*)(ws + WS_XB), (const bf16_t*)(ws + WS_WCQ) + (size_t)l * DM * DM, DM, DM, DM, nullptr};
            pg8::GridOrder<0> S; S.init(T / 256, DM / 256, G, bx, DM, DM);
            pg8::EpiBf16S E{(bf16_t*)(ws + WS_Q), DM, C2_CROSS, nullptr, 0, 1};
            pg8::gemm_phase<pg8::EpiBf16S, pg8::GridOrder<0>, false, true>(ptid, lds + RING_OFF, xch, g, S, E);
            SEAM(pb + 4);
        }
        REP(7) if (PH_ON(7) && IN(pb + 5)) {
            PHASE_TID(); unsigned char* ws = WSP();
            pg8::Gemm g{(const bf16_t*)(ws + WS_Q), (const bf16_t*)(ws + WS_KC) + (size_t)l * TM * DM, DM, DM, 256, nullptr};
            pg8::GridOrder<1> S; S.init(T / 256, 4, G, bx, DM, DM);
            pg8::EpiSoftmax E{(bf16_t*)(ws + WS_K)};
            pg8::gemm_phase<pg8::EpiSoftmax, pg8::GridOrder<1>, false, true>(ptid, lds + RING_OFF, xch, g, S, E);
            SEAM(pb + 5);
        }
        REP(8) if (PH_ON(8) && IN(pb + 6)) {
            PHASE_TID(); unsigned char* ws = WSP();
            pg8::Gemm g{(const bf16_t*)(ws + WS_K), (const bf16_t*)(ws + WS_VT) + (size_t)l * TM * DM, DM, TM, 256, nullptr};
            pg8::GridOrder<2> S; S.init(T / 256, 4, G, bx, DM, TM);
            pg8::EpiBf16S E{(bf16_t*)(ws + WS_V), DM, 1.0f, nullptr, 0, 1};
            pg8::gemm_phase<pg8::EpiBf16S, pg8::GridOrder<2>, false, true>(ptid, lds + RING_OFF, xch, g, S, E);
            SEAM(pb + 6);
        }
        REP(9) if (PH_ON(9) && IN(pb + 7)) {
            PHASE_TID(); unsigned char* ws = WSP(); float* X = (float*)ARGF(22);
            pg8::Gemm g{(const bf16_t*)(ws + WS_V), (const bf16_t*)(ws + WS_WCO) + (size_t)l * DM * DM, DM, DM, DM, nullptr};
            pg8::GridOrder<0> S; S.init(T / 256, DM / 256, G, bx, DM, DM);
            pg8::EpiResid E{X, X};
            pg8::gemm_phase<pg8::EpiResid, pg8::GridOrder<0>, false, true>(ptid, lds + RING_OFF, xch, g, S, E);
            SEAM(pb + 7);
        }
        REP(10) if (PH_ON(10) && IN(pb + 8)) {
            PHASE_TID(); unsigned char* ws = WSP(); float* X = (float*)ARGF(22); bf16_t* XB = (bf16_t*)(ws + WS_XB); const int gw = vcu * NWAVES + wave; gu32* ctl = (gu32*)ws;
            const float* w_router = ARGF(14); const float* b_router = ARGF(15); const float* ln2_g = ARGF(12); const float* ln2_b = ARGF(13);
            int* ASGE = (int*)(ws + WS_ASGE); int* ASGR = (int*)(ws + WS_ASGR); float* ASGG = (float*)(ws + WS_ASGG); int* STOK = (int*)(ws + WS_STOK);
            const int tid = ptid;
            constexpr int RWS = 1028;
            LAS float* wl = (LAS float*)(lds + RING_OFF);
            LAS int* sE = (LAS int*)(lds + RING_OFF + NE * RWS * 4); LAS float* sG = (LAS float*)(sE + 512); LAS int* cntw = (LAS int*)(sG + 512); LAS int* basew = cntw + 256;
            { const float* wr_l = w_router + (size_t)l * DM * NE;
              for (int idx = tid; idx < DM * NE / 4; idx += NWAVES * 64) { const int k = idx >> 3, e4 = (idx & 7) * 4; const f32x4 w4 = *(const f32x4*)(wr_l + (size_t)k * NE + e4);
                  wl[(e4 + 0) * RWS + k] = w4[0]; wl[(e4 + 1) * RWS + k] = w4[1]; wl[(e4 + 2) * RWS + k] = w4[2]; wl[(e4 + 3) * RWS + k] = w4[3]; } }
            __syncthreads();
            gu32* cnt_l = ctl + CW_CNT + l * NE * 64;
            for (int rg = gw; rg < T / 16; rg += NGW) {
#pragma unroll 1
                for (int g4 = 0; g4 < 4; ++g4) {
                    int lo_ = lane; asm volatile("" : "+v"(lo_));
                    const int t0 = rg * 16 + g4 * 4; f32x4 xn[4][4];
                    { f32x4 gg[4], bb[4]; row_load(ln2_g + (size_t)l * DM, lo_, gg); row_load(ln2_b + (size_t)l * DM, lo_, bb);
#pragma unroll
                      for (int r = 0; r < 4; ++r) { const size_t t = (size_t)(t0 + r); row_load(X + t * DM, lo_, xn[r]); row_layernorm(xn[r], gg, bb);
                          row_store_f32(X + t * DM, lo_, xn[r]); row_store_bf16(XB + t * DM, lo_, xn[r]); } }
                    float vv[4]; const int eb = (lo_ >> 1) & 7;
#pragma unroll
                    for (int c = 0; c < 4; ++c) { const LAS float* wlo = wl + c * 8 * RWS; asm volatile("" : "+v"(wlo));
                        float acc[32]; thin_dot<8>(xn, wlo, RWS, lo_, acc); butterfly32(acc, lo_); vv[c] = acc[0] + b_router[l * NE + c * 8 + eb]; }
                    float topv[4]; int tope[4];
#pragma unroll
                    for (int k = 0; k < 4; ++k) { float bv = vv[0]; int be = eb;
#pragma unroll
                        for (int c = 1; c < 4; ++c) { if (vv[c] > bv) { bv = vv[c]; be = c * 8 + eb; } }
#pragma unroll
                        for (int o = 1; o < 16; o <<= 1) { const float ov = __shfl_xor(bv, o); const int oe = __shfl_xor(be, o); const bool take = (ov > bv) || (ov == bv && oe < be); bv = take ? ov : bv; be = take ? oe : be; }
                        topv[k] = bv; tope[k] = be;
#pragma unroll
                        for (int c = 0; c < 4; ++c) if (be == c * 8 + eb) vv[c] = -INFINITY; }
                    const float p1 = __expf(topv[1] - topv[0]), p2 = __expf(topv[2] - topv[0]), p3 = __expf(topv[3] - topv[0]); const float rs = 1.0f / (1.0f + p1 + p2 + p3);
                    const int kk = lo_ & 15;
                    if (kk < 4) { const int me = kk == 0 ? tope[0] : kk == 1 ? tope[1] : kk == 2 ? tope[2] : tope[3]; const float mg = (kk == 0 ? 1.0f : kk == 1 ? p1 : kk == 2 ? p2 : p3) * rs;
                        const int slot = wave * 64 + (g4 * 4 + (lo_ >> 4)) * 4 + kk; sE[slot] = me; sG[slot] = mg; }
                }
                LDS_WAIT();
                int lq_ = lane; asm volatile("" : "+v"(lq_));
                const int my_e = sE[wave * 64 + lq_]; const float my_g = sG[wave * 64 + lq_]; const int my_t = rg * 16 + (lq_ >> 2);
                int lr = 0, mycnt = 0;
#pragma unroll 1
                for (int e = 0; e < NE; ++e) { const unsigned long long m = __ballot(my_e == e); if (my_e == e) lr = __popcll(m & ((1ull << lq_) - 1ull)); if (lq_ == e) mycnt = __popcll(m); }
                if (lq_ < NE) cntw[wave * NE + lq_] = mycnt;
                __syncthreads();
                int tq_ = tid; asm volatile("" : "+v"(tq_));
                if (tq_ < NE) { int tot = 0; int c8[NWAVES];
#pragma unroll
                    for (int w = 0; w < NWAVES; ++w) { c8[w] = cntw[w * NE + tq_]; tot += c8[w]; }
                    int base = 0; if (tot > 0) base = (int)__hip_atomic_fetch_add(cnt_l + tq_ * 64, (unsigned)tot, __ATOMIC_RELAXED, __HIP_MEMORY_SCOPE_AGENT);
#pragma unroll
                    for (int w = 0; w < NWAVES; ++w) { basew[w * NE + tq_] = base; base += c8[w]; } }
                __syncthreads();
                const int rank = basew[wave * NE + my_e] + lr;
                ASGE[(size_t)my_t * 4 + (lq_ & 3)] = my_e; ASGR[(size_t)my_t * 4 + (lq_ & 3)] = rank; ASGG[(size_t)my_t * 4 + (lq_ & 3)] = my_g;
                STOK[(size_t)my_e * ECAP + rank] = my_t;
                __syncthreads();
            }
            SEAM(pb + 8);
        }
        if ((PH_ON(11) && IN(pb + 9)) || (PH_ON(12) && IN(pb + 10)) || (PH_ON(13) && IN(pb + 11))) {
            PHASE_TID(); gu32* ctl = (gu32*)WSP();
            __syncthreads();
            if (ptid < NE) CNT[ptid] = (int)__hip_atomic_load(ctl + CW_CNT + (l * NE + ptid) * 64, __ATOMIC_RELAXED, __HIP_MEMORY_SCOPE_AGENT);
            __syncthreads();
            if (ptid == 0) { int a = 0; for (int e = 0; e < NE; ++e) { TP[e] = a; a += (CNT[e] + 255) >> 8; } TP[NE] = a; }
            __syncthreads();
        }
        REP(11) if (PH_ON(11) && IN(pb + 9)) {
            PHASE_TID(); unsigned char* ws = WSP();
            pg8::Gemm g{(const bf16_t*)(ws + WS_XB), (const bf16_t*)(ws + WS_WGU) + (size_t)l * NE * 2048 * DM, DM, DM, DM, (const int*)(ws + WS_STOK)};
            pg8::MoeOrder<8, true> S; S.init(TP, CNT, G, bx);
            pg8::EpiSwiglu E{(bf16_t*)(ws + WS_ACT), ARGF(17) + (size_t)l * NE * 2048};
            pg8::gemm_phase<pg8::EpiSwiglu, pg8::MoeOrder<8, true>, true, true>(ptid, lds + RING_OFF, xch, g, S, E);
            SEAM(pb + 9);
        }
        REP(12) if (PH_ON(12) && IN(pb + 10)) {
            PHASE_TID(); unsigned char* ws = WSP();
            pg8::Gemm g{(const bf16_t*)(ws + WS_ACT), (const bf16_t*)(ws + WS_WD) + (size_t)l * NE * DM * DM, DM, DM, DM, nullptr};
            pg8::MoeOrder<4, false> S; S.init(TP, CNT, G, bx);
            pg8::EpiBf16S E{(bf16_t*)(ws + WS_YEXP), DM, 1.0f, ARGF(19) + (size_t)l * NE * DM, DM, 256};
            pg8::gemm_phase<pg8::EpiBf16S, pg8::MoeOrder<4, false>, false, true>(ptid, lds + RING_OFF, xch, g, S, E);
            SEAM(pb + 10);
        }
        REP(13) if (PH_ON(13) && IN(pb + 11)) {
            PHASE_TID(); unsigned char* ws = WSP(); float* X = (float*)ARGF(22); const int gw = vcu * NWAVES + wave;
            bf16_t* XB = (bf16_t*)(ws + WS_XB); const int* ASGE = (const int*)(ws + WS_ASGE); const int* ASGR = (const int*)(ws + WS_ASGR); const float* ASGG = (const float*)(ws + WS_ASGG);
            const bf16_t* YEXP = (const bf16_t*)(ws + WS_YEXP); float* LOGF = (float*)(ws + WS_LOGF); const float* b_forget = ARGF(3);
            LAS float* wf = (LAS float*)(lds + RING_OFF);
            if (l + 1 < NL) { load_wf(ARGF(2) + (size_t)(l + 1) * DM * IN_COLS, wf, ptid); __syncthreads(); }
            f32x4 gg[4], bb[4]; row_load(ARGF(20) + (size_t)l * DM, lane, gg); row_load(ARGF(21) + (size_t)l * DM, lane, bb);
            for (int rg = gw; rg < T / 16; rg += NGW)
                for (int g4 = 0; g4 < 4; ++g4) { const int t0 = rg * 16 + g4 * 4; f32x4 xn[4][4];
#pragma unroll
                    for (int r = 0; r < 4; ++r) { const size_t t = (size_t)(t0 + r); row_load(X + t * DM, lane, xn[r]);
#pragma unroll
                        for (int j = 0; j < 4; ++j) xn[r][j] = xn[r][j] * DN_ALPHA;
#pragma unroll
                        for (int k = 0; k < 4; ++k) { const int e = ASGE[t * 4 + k], rk = ASGR[t * 4 + k]; const float gt = ASGG[t * 4 + k];
                            const GAS u32x2* yr = (const GAS u32x2*)(YEXP + ((size_t)TP[e] * 256 + rk) * DM) + lane;
#pragma unroll
                            for (int j = 0; j < 4; ++j) { const u32x2 w = yr[64 * j];
                                xn[r][j][0] += gt * __uint_as_float(w.x << 16); xn[r][j][1] += gt * __uint_as_float(w.x & 0xffff0000u);
                                xn[r][j][2] += gt * __uint_as_float(w.y << 16); xn[r][j][3] += gt * __uint_as_float(w.y & 0xffff0000u); } }
                        row_layernorm(xn[r], gg, bb); row_store_f32(X + t * DM, lane, xn[r]); row_store_bf16(XB + t * DM, lane, xn[r]); }
                    if (l + 1 < NL) forget_rows(xn, wf, b_forget + (l + 1) * 8, LOGF, t0, lane); }
            __syncthreads();
            SEAM(pb + 11);
        }
    }
#undef IN
#undef BOTH
#undef SEAM
}

#ifndef MK_PER_PHASE
#define MK_PER_PHASE 0
#endif
extern "C" void kernel_launch(void* const* d_in, const int* in_sizes, int n_in, void* d_out, int out_size, void* d_ws, size_t ws_size, hipStream_t stream) {
    static int grid = 0;
    if (grid == 0) {
        if (n_in != 22 || in_sizes[0] != T * DM || out_size != T * DM || ws_size < WS_END) {
            fprintf(stderr, "kernel_launch: built for 22 inputs, x/out of %d floats, >= %zu bytes of workspace; got n_in %d, in0 %d, out %d, ws %zu; nothing launched\n", T * DM, (size_t)WS_END, n_in, n_in > 0 ? in_sizes[0] : -1, out_size, ws_size); grid = -1; return; }
        int dev = 0, cus = 0, per_cu = 0;
        if (hipGetDevice(&dev) != hipSuccess || hipDeviceGetAttribute(&cus, hipDeviceAttributeMultiprocessorCount, dev) != hipSuccess) { fprintf(stderr, "kernel_launch: device query failed\n"); grid = -1; return; }
        if (hipFuncSetAttribute((const void*)skel_fwd, hipFuncAttributeMaxDynamicSharedMemorySize, LDS_BYTES) != hipSuccess) { fprintf(stderr, "kernel_launch: hipFuncSetAttribute failed\n"); grid = -1; return; }
        if (hipOccupancyMaxActiveBlocksPerMultiprocessor(&per_cu, (const void*)skel_fwd, NWAVES * 64, LDS_BYTES) != hipSuccess || per_cu < 1)
            fprintf(stderr, "kernel_launch: note: occupancy query reports %d workgroups per CU\n", per_cu);
        (void)hipGetLastError();
        grid = cus;
    }
    if (grid < 0) return;
    if (hipMemsetAsync((char*)d_ws + WS_CTL, 0, CTL_ZERO_BYTES, stream) != hipSuccess) { fprintf(stderr, "kernel_launch: memset failed\n"); return; }
    Args a{};
    for (int i = 0; i < 22; ++i) a.in[i] = (const float*)d_in[i];
    a.out = (float*)d_out; a.ws = (unsigned char*)d_ws;
#if MK_PER_PHASE
    for (int p = 0; p < NPHASE; ++p) { a.ph_lo = p; a.ph_hi = p + 1; hipLaunchKernelGGL(skel_fwd, dim3(grid), dim3(NWAVES * 64), LDS_BYTES, stream, a); }
#else
    a.ph_lo = 0; a.ph_hi = NPHASE; hipLaunchKernelGGL(skel_fwd, dim3(grid), dim3(NWAVES * 64), LDS_BYTES, stream, a);
#endif
    const hipError_t le = hipPeekAtLastError();
    if (le != hipSuccess) fprintf(stderr, "kernel_launch: launch failed: %s\n", hipGetErrorName(le));
}
```

```cpp
#define REPEAT_MASK 0
#include <hip/hip_runtime.h>
#include <cstdio>
#include <cstdint>
#include <cmath>

#define GAS __attribute__((address_space(1)))
#define LAS __attribute__((address_space(3)))
typedef unsigned short bf16_t;
typedef short bf16x8 __attribute__((ext_vector_type(8)));
typedef float f32x4 __attribute__((ext_vector_type(4)));
typedef float f32x2 __attribute__((ext_vector_type(2)));
typedef float f32x16 __attribute__((ext_vector_type(16)));
typedef unsigned u32x4 __attribute__((ext_vector_type(4)));
typedef unsigned u32x2 __attribute__((ext_vector_type(2)));
typedef short s16x4 __attribute__((ext_vector_type(4)));

constexpr int NB = 16, SEQ = 2048, DM = 1024, NL = 4, T = NB * SEQ;
constexpr int NMEM = 256, TM = NB * NMEM;
constexpr int NE = 32, TOPK = 4, TK = T * TOPK;
constexpr int IN_COLS = 3080, IN_N = 3072;
constexpr int FCOL = 1536;
constexpr float LN_EPS = 1e-5f;
constexpr float DN_ALPHA = 1.681792830507429f;
constexpr float LOG2E = 1.4426950408889634f;
constexpr float C2_ATT = 0.125f * LOG2E;
constexpr float C2_CROSS = 0.0625f * LOG2E;
constexpr int ECAP = 32768;
constexpr int MAXTILES = 544;

__device__ __forceinline__ unsigned cvt_pk_bf16(float lo, float hi) { unsigned r; asm volatile("v_cvt_pk_bf16_f32 %0, %1, %2" : "=v"(r) : "v"(lo), "v"(hi)); return r; }
__device__ __forceinline__ float bf2f(unsigned short b) { return __uint_as_float((unsigned)b << 16); }
#include <hip/hip_bf16.h>
typedef GAS unsigned gu32;
typedef GAS unsigned long long gu64;
#define RLX_AGENT __ATOMIC_RELAXED, __HIP_MEMORY_SCOPE_AGENT
namespace pg8 {
constexpr int BM = 256, BK = 64, HALF = 128, HTB = HALF * BK * 2  , STAGE_BYTES = 8 * HTB, NXCD = 8, WGM = 8;

__host__ __device__ __forceinline__ int lds_byte(int r, int c) { const int st = (r >> 4) * 2 + (c >> 5), rr = r & 15, cc = c & 31, ob = rr * 64 + cc * 2; return st * 1024 + (ob ^ (((ob >> 9) & 1) << 5)); }
__host__ __device__ __forceinline__ void stage_rc(int b, int& R, int& C) { const int st = b / 1024, sb = b % 1024, swz = sb ^ (((sb >> 9) & 1) << 5); R = (st >> 1) * 16 + swz / 64; C = (st & 1) * 32 + (swz % 64) / 2; }
__host__ __device__ __forceinline__ int perm32(int rho) { const int n = rho >> 4, i = rho & 15; return 8 * (i >> 2) + 4 * n + (i & 3); }

struct Unit { long abyte, bbyte; int orow, ocol, aux, grow, gcnt; };
struct Gemm { const bf16_t* A; const bf16_t* Bt; int lda, ldb, K; const int* gtok; };

__device__ __forceinline__ int xcd_chunk(int L, int nwg) { const int q = nwg / NXCD, r = nwg % NXCD, xcd = L % NXCD, off = L / NXCD; return (xcd < r ? xcd * (q + 1) : r * (q + 1) + (xcd - r) * q) + off; }

template <int MODE> struct GridOrder {
    int nM, nN, nwg, G, c, lda, ldb;
    __device__ __forceinline__ void init(int nM_, int nN_, int G_, int c_, int lda_, int ldb_) { nM = nM_; nN = nN_; nwg = nM * nN; G = G_; c = c_; lda = lda_; ldb = ldb_; }
    __device__ __forceinline__ bool next(int i, Unit& u) const {
        const long L = (long)i * G + c; if (L >= nwg) return false;
        const int wgid = xcd_chunk((int)L, nwg);
        const int nig = WGM * nN, gid = wgid / nig, fm = gid * WGM, gsz = (nM - fm) < WGM ? (nM - fm) : WGM;
        const int pm = fm + ((wgid % nig) % gsz), pn = (wgid % nig) / gsz;
        u.orow = pm * BM; u.ocol = pn * BM; u.aux = pn; u.grow = 0; u.gcnt = BM;
        if (MODE == 0) { u.abyte = (long)pm * BM * lda * 2; u.bbyte = (long)pn * BM * ldb * 2; }
        else { const int b = pm >> 3; u.abyte = (long)pm * BM * lda * 2 + pn * 512;
               u.bbyte = (MODE == 1) ? ((long)b * 256 * ldb + pn * 256) * 2 : ((long)pn * 256 * ldb + b * 256) * 2; }
        return true;
    }
};
template <int NPN, bool GATHER> struct MoeOrder {
    const LAS int* tp; const LAS int* cnt; int nwg, G, c;
    __device__ __forceinline__ void init(const LAS int* tp_, const LAS int* cnt_, int G_, int c_) { tp = tp_; cnt = cnt_; G = G_; c = c_; nwg = __builtin_amdgcn_readfirstlane(tp_[32]) * NPN; }
    __device__ __forceinline__ bool next(int i, Unit& u) const {
        const long L = (long)i * G + c; if (L >= nwg) return false;
        const int wgid = xcd_chunk((int)L, nwg);
        int e = 0;
#pragma unroll
        for (int k = 16; k >= 1; k >>= 1) { const int v = __builtin_amdgcn_readfirstlane(tp[e + k]); if (v * NPN <= wgid) e += k; }
        const int t0 = __builtin_amdgcn_readfirstlane(tp[e]), t1 = __builtin_amdgcn_readfirstlane(tp[e + 1]), ce = __builtin_amdgcn_readfirstlane(cnt[e]);
        const int r = wgid - t0 * NPN, nte = t1 - t0, j = r % nte, pn = r / nte;
        u.aux = e; u.grow = e * ECAP + j * BM; u.gcnt = (ce - j * BM) < BM ? (ce - j * BM) : BM;
        u.orow = (t0 + j) * BM; u.ocol = pn;
        u.abyte = GATHER ? 0 : (long)(t0 + j) * BM * DM * 2;
        u.bbyte = (long)(e * NPN + pn) * BM * DM * 2;
        return true;
    }
};

struct EpiCtx { int wr, wc, fr, fq, wid, lane; LAS unsigned char* xch; };

struct EpiQKV {
    static constexpr bool PERM = true;
    bf16_t *Q, *K, *V; float* kpart;
    __device__ __forceinline__ void operator()(const f32x4 (&acc)[2][2][4][2], const Unit& u, const EpiCtx& c) const {
        const int pn = u.aux, ts = (pn >> 1) % 3, grp = pn / 6;
        bf16_t* base = (ts == 0) ? Q : ((ts == 1) ? K : V);
        const float sc = (ts == 0) ? C2_ATT : 1.f;
        const int row0 = u.orow + c.wr * 64 + c.fr, col0 = grp * 512 + (pn & 1) * 256 + c.wc * 32 + 8 * c.fq;
#pragma unroll
        for (int ai = 0; ai < 2; ++ai)
#pragma unroll
            for (int m = 0; m < 4; ++m) { bf16_t* rowp = base + (size_t)(row0 + ai * HALF + m * 16) * DM + col0;
#pragma unroll
                for (int bj = 0; bj < 2; ++bj) { const f32x4 v0 = acc[ai][bj][m][0] * sc, v1 = acc[ai][bj][m][1] * sc;
                    u32x4 w; w.x = cvt_pk_bf16(v0[0], v0[1]); w.y = cvt_pk_bf16(v0[2], v0[3]); w.z = cvt_pk_bf16(v1[0], v1[1]); w.w = cvt_pk_bf16(v1[2], v1[3]);
                    *(u32x4*)(rowp + bj * HALF) = w; } }
        if (pn == 8 || pn == 9) {
#pragma unroll
            for (int bj = 0; bj < 2; ++bj)
#pragma unroll
                for (int n = 0; n < 2; ++n) { f32x4 s = (f32x4){0.f, 0.f, 0.f, 0.f};
#pragma unroll
                    for (int ai = 0; ai < 2; ++ai)
#pragma unroll
                        for (int m = 0; m < 4; ++m) s += acc[ai][bj][m][n];
#pragma unroll
                    for (int o = 1; o < 16; o <<= 1) { s[0] += __shfl_xor(s[0], o); s[1] += __shfl_xor(s[1], o); s[2] += __shfl_xor(s[2], o); s[3] += __shfl_xor(s[3], o); }
                    if (c.fr == 0) *(f32x4*)(kpart + (size_t)((u.orow >> 8) * 2 + c.wr) * 512 + (pn - 8) * 256 + bj * HALF + c.wc * 32 + 8 * c.fq + 4 * n) = s; }
        }
    }
};
struct EpiResid {
    static constexpr bool PERM = false;
    const float* res; float* out;
    __device__ __forceinline__ void operator()(const f32x4 (&acc)[2][2][4][2], const Unit& u, const EpiCtx& c) const {
        const int row0 = u.orow + c.wr * 64 + c.fr, col0 = u.ocol + c.wc * 32 + 4 * c.fq;
#pragma unroll
        for (int ai = 0; ai < 2; ++ai)
#pragma unroll
            for (int m = 0; m < 4; ++m) { const size_t off = (size_t)(row0 + ai * HALF + m * 16) * DM + col0;
#pragma unroll
                for (int bj = 0; bj < 2; ++bj)
#pragma unroll
                    for (int n = 0; n < 2; ++n) { const f32x4 r = *(const f32x4*)(res + off + bj * HALF + n * 16); *(f32x4*)(out + off + bj * HALF + n * 16) = r * DN_ALPHA + acc[ai][bj][m][n]; } }
    }
};
struct EpiBf16S {
    static constexpr bool PERM = true;
    bf16_t* O; int ldc; float scale; const float* bias; int bstride; int cmul;
    __device__ __forceinline__ void operator()(const f32x4 (&acc)[2][2][4][2], const Unit& u, const EpiCtx& c) const {
        const int row0 = u.orow + c.wr * 64 + c.fr, col0 = u.ocol * cmul + c.wc * 32 + 8 * c.fq;
        f32x4 bv[2][2];
#pragma unroll
        for (int bj = 0; bj < 2; ++bj)
#pragma unroll
            for (int n = 0; n < 2; ++n) bv[bj][n] = bias ? *(const f32x4*)(bias + (size_t)u.aux * bstride + col0 + bj * HALF + 4 * n) : (f32x4){0.f, 0.f, 0.f, 0.f};
#pragma unroll
        for (int ai = 0; ai < 2; ++ai)
#pragma unroll
            for (int m = 0; m < 4; ++m) { bf16_t* rowp = O + (size_t)(row0 + ai * HALF + m * 16) * ldc + col0;
#pragma unroll
                for (int bj = 0; bj < 2; ++bj) { const f32x4 v0 = (acc[ai][bj][m][0] + bv[bj][0]) * scale, v1 = (acc[ai][bj][m][1] + bv[bj][1]) * scale;
                    u32x4 w; w.x = cvt_pk_bf16(v0[0], v0[1]); w.y = cvt_pk_bf16(v0[2], v0[3]); w.z = cvt_pk_bf16(v1[0], v1[1]); w.w = cvt_pk_bf16(v1[2], v1[3]);
                    *(u32x4*)(rowp + bj * HALF) = w; } }
    }
};
struct EpiSwiglu {
    static constexpr bool PERM = true;
    bf16_t* O; const float* bias;
    __device__ __forceinline__ void operator()(const f32x4 (&acc)[2][2][4][2], const Unit& u, const EpiCtx& c) const {
        const int row0 = u.orow + c.wr * 64 + c.fr, col0 = u.ocol * HALF + c.wc * 32 + 8 * c.fq;
        const float* bp = bias + (size_t)u.aux * 2048 + col0;
        f32x4 bg[2], bu[2];
#pragma unroll
        for (int n = 0; n < 2; ++n) { bg[n] = *(const f32x4*)(bp + 4 * n); bu[n] = *(const f32x4*)(bp + 1024 + 4 * n); }
#pragma unroll
        for (int ai = 0; ai < 2; ++ai)
#pragma unroll
            for (int m = 0; m < 4; ++m) { float o[8];
#pragma unroll
                for (int n = 0; n < 2; ++n)
#pragma unroll
                    for (int i = 0; i < 4; ++i) { float gv = acc[ai][0][m][n][i] + bg[n][i], uv = acc[ai][1][m][n][i] + bu[n][i];
                        gv = fminf(gv, 7.0f); uv = fminf(fmaxf(uv, -7.0f), 7.0f);
                        const float sg = __builtin_amdgcn_rcpf(1.0f + __builtin_amdgcn_exp2f(gv * (-1.702f * LOG2E)));
                        o[n * 4 + i] = (uv + 1.0f) * (gv * sg); }
                u32x4 w; w.x = cvt_pk_bf16(o[0], o[1]); w.y = cvt_pk_bf16(o[2], o[3]); w.z = cvt_pk_bf16(o[4], o[5]); w.w = cvt_pk_bf16(o[6], o[7]);
                *(u32x4*)(O + (size_t)(row0 + ai * HALF + m * 16) * DM + col0) = w; }
    }
};
struct EpiSoftmax {
    static constexpr bool PERM = true;
    bf16_t* O;
    __device__ __forceinline__ void operator()(f32x4 (&acc)[2][2][4][2], const Unit& u, const EpiCtx& c0) const {
        EpiCtx c = c0; asm volatile("" : "+v"(c.fr), "+v"(c.fq));
        LAS float* MX = (LAS float*)c.xch;
        LAS float* SM = (LAS float*)(c.xch + 4096);
#pragma unroll
        for (int ai = 0; ai < 2; ++ai)
#pragma unroll
            for (int m = 0; m < 4; ++m) { float mx = -INFINITY;
#pragma unroll
                for (int bj = 0; bj < 2; ++bj)
#pragma unroll
                    for (int n = 0; n < 2; ++n) { const f32x4 x = acc[ai][bj][m][n]; mx = fmaxf(mx, fmaxf(fmaxf(x[0], x[1]), fmaxf(x[2], x[3]))); }
                mx = fmaxf(mx, __shfl_xor(mx, 16)); mx = fmaxf(mx, __shfl_xor(mx, 32));
                if (c.fq == 0) MX[(ai * HALF + c.wr * 64 + m * 16 + c.fr) * 4 + c.wc] = mx; }
        asm volatile("s_waitcnt lgkmcnt(0)" ::: "memory"); __builtin_amdgcn_s_barrier(); asm volatile("" ::: "memory");
#pragma unroll
        for (int ai = 0; ai < 2; ++ai)
#pragma unroll
            for (int m = 0; m < 4; ++m) { const int r = ai * HALF + c.wr * 64 + m * 16 + c.fr; const f32x4 mm = *(const LAS f32x4*)(MX + r * 4);
                const float mx = fmaxf(fmaxf(mm[0], mm[1]), fmaxf(mm[2], mm[3])); float s = 0.f;
#pragma unroll
                for (int bj = 0; bj < 2; ++bj)
#pragma unroll
                    for (int n = 0; n < 2; ++n) { f32x4 x = acc[ai][bj][m][n];
                        x[0] = __builtin_amdgcn_exp2f(x[0] - mx); x[1] = __builtin_amdgcn_exp2f(x[1] - mx); x[2] = __builtin_amdgcn_exp2f(x[2] - mx); x[3] = __builtin_amdgcn_exp2f(x[3] - mx);
                        s += (x[0] + x[1]) + (x[2] + x[3]); acc[ai][bj][m][n] = x; }
                s += __shfl_xor(s, 16); s += __shfl_xor(s, 32);
                if (c.fq == 0) SM[r * 4 + c.wc] = s; __builtin_amdgcn_sched_barrier(0); }
        asm volatile("s_waitcnt lgkmcnt(0)" ::: "memory"); __builtin_amdgcn_s_barrier(); asm volatile("" ::: "memory");
        const int row0 = u.orow + c.wr * 64 + c.fr, col0 = u.ocol + c.wc * 32 + 8 * c.fq;
#pragma unroll
        for (int ai = 0; ai < 2; ++ai)
#pragma unroll
            for (int m = 0; m < 4; ++m) { const int r = ai * HALF + c.wr * 64 + m * 16 + c.fr; const f32x4 ss = *(const LAS f32x4*)(SM + r * 4);
                const float rl = 1.0f / ((ss[0] + ss[1]) + (ss[2] + ss[3]));
                bf16_t* rowp = O + (size_t)(row0 + ai * HALF + m * 16) * DM + col0;
#pragma unroll
                for (int bj = 0; bj < 2; ++bj) { const f32x4 v0 = acc[ai][bj][m][0] * rl, v1 = acc[ai][bj][m][1] * rl;
                    u32x4 w; w.x = cvt_pk_bf16(v0[0], v0[1]); w.y = cvt_pk_bf16(v0[2], v0[3]); w.z = cvt_pk_bf16(v1[0], v1[1]); w.w = cvt_pk_bf16(v1[2], v1[3]);
                    *(u32x4*)(rowp + bj * HALF) = w; } __builtin_amdgcn_sched_barrier(0); }
    }
};

template <class Epi, class Sched, bool GATHER, bool ALIGN_EPI>
__device__ __forceinline__ void gemm_phase(int tid, LAS unsigned char* lds, LAS unsigned char* xch, const Gemm g, const Sched& S, const Epi& E) {
    const int wid = __builtin_amdgcn_readfirstlane(tid >> 6), lane = tid & 63, wr = wid >> 2, wc = wid & 3, fr = lane & 15, fq = lane >> 4;
    int Kv = g.K; asm volatile("" : "+s"(Kv));
    const int nt = Kv / BK;
    EpiCtx ctx; ctx.wr = wr; ctx.wc = wc; ctx.fr = fr; ctx.fq = fq; ctx.wid = wid; ctx.lane = lane; ctx.xch = xch;
    unsigned oB[2], oAc[2][2], oAn[2][2];
#pragma unroll
    for (int i = 0; i < 2; ++i) { int R, C; stage_rc(tid * 16 + i * 8192, R, C); const int Rb = Epi::PERM ? ((R & ~31) + perm32(R & 31)) : R;
        oB[i] = (unsigned)(Rb * g.ldb + C) * 2u;
        oAc[0][i] = (unsigned)(R * g.lda + C) * 2u; oAc[1][i] = oAc[0][i] + (unsigned)(HALF * g.lda * 2); oAn[0][i] = oAc[0][i]; oAn[1][i] = oAc[1][i]; }
    const size_t kstep = (size_t)(BK * 2);
    const size_t hstepB = (size_t)HALF * g.ldb * 2;
    const unsigned ldsw = (unsigned)wid * 1024u;
    const int aoff = lds_byte(wr * 64 + fr, fq * 8), boff = lds_byte(wc * 32 + fr, fq * 8);
#define PG8_SA(b, h) (((b) * 2 + (h)) * HTB)
#define PG8_SB(b, h) ((4 + (b) * 2 + (h)) * HTB)
#define PG8_STAGE(bufoff, gbase, o0, o1) do { \
        __builtin_amdgcn_global_load_lds((const unsigned*)((const char*)(gbase) + (o0)), (LAS unsigned*)(lds + (bufoff) + ldsw), 16, 0, 0); \
        __builtin_amdgcn_global_load_lds((const unsigned*)((const char*)(gbase) + (o1)), (LAS unsigned*)(lds + (bufoff) + ldsw + 8192), 16, 0, 0); } while (0)
#define PG8_STAGE_B(bufoff, gbase) PG8_STAGE(bufoff, gbase, oB[0], oB[1])
#define PG8_LDA(dst, b, h) do { _Pragma("unroll") for (int m = 0; m < 4; ++m) _Pragma("unroll") for (int k = 0; k < 2; ++k) dst[m][k] = *(const LAS bf16x8*)(lds + PG8_SA(b, h) + aoff + m * 2048 + k * 1024); } while (0)
#define PG8_LDB(dst, b, h) do { _Pragma("unroll") for (int n = 0; n < 2; ++n) _Pragma("unroll") for (int k = 0; k < 2; ++k) dst[n][k] = *(const LAS bf16x8*)(lds + PG8_SB(b, h) + boff + n * 2048 + k * 1024); } while (0)
#define PG8_MMA(ai, bj, At, Bt) do { __builtin_amdgcn_s_setprio(1); _Pragma("unroll") for (int m = 0; m < 4; ++m) _Pragma("unroll") for (int n = 0; n < 2; ++n) _Pragma("unroll") for (int k = 0; k < 2; ++k) \
        acc[ai][bj][m][n] = __builtin_amdgcn_mfma_f32_16x16x32_bf16(Bt[n][k], At[m][k], acc[ai][bj][m][n], 0, 0, 0); __builtin_amdgcn_s_setprio(0); } while (0)
#define PG8_WAIT_V(n) asm volatile("s_waitcnt vmcnt(" #n ")" ::: "memory")
#define PG8_WAIT_L(n) asm volatile("s_waitcnt lgkmcnt(" #n ")" ::: "memory")
#define PG8_BAR __builtin_amdgcn_s_barrier()
#define PG8_SCHED __builtin_amdgcn_sched_barrier(0)
#define PG8_TOK_LOAD(U, tk) do { int t_ = tid; asm volatile("" : "+v"(t_)); _Pragma("unroll") for (int i = 0; i < 2; ++i) { int R_, C_; stage_rc(t_ * 16 + i * 8192, R_, C_); _Pragma("unroll") for (int h = 0; h < 2; ++h) { \
        const int r_ = h * HALF + R_; tk[h][i] = (r_ < (U).gcnt) ? ((const GAS int*)g.gtok)[(U).grow + r_] : 0; } } } while (0)
#define PG8_TOK_OFF(tk, set) do { int t_ = tid; asm volatile("" : "+v"(t_)); _Pragma("unroll") for (int i = 0; i < 2; ++i) { int R_, C_; stage_rc(t_ * 16 + i * 8192, R_, C_); _Pragma("unroll") for (int h = 0; h < 2; ++h) { \
        set[h][i] = (unsigned)(tk[h][i] * g.lda + C_) * 2u; asm volatile("" : "+v"(set[h][i])); } } } while (0)
    Unit cur, nxt, nn; int ui = 0;
    if (!S.next(0, cur)) return;
    bool has_next = S.next(1, nxt);
    if constexpr (GATHER) {
        int tk[2][2]; PG8_TOK_LOAD(cur, tk); PG8_TOK_OFF(tk, oAc);
        if (has_next) { PG8_TOK_LOAD(nxt, tk); PG8_TOK_OFF(tk, oAn); }
        else {
#pragma unroll
            for (int h = 0; h < 2; ++h)
#pragma unroll
                for (int i = 0; i < 2; ++i) oAn[h][i] = oAc[h][i]; }
    }
    f32x4 acc[2][2][4][2];
#pragma unroll
    for (int a = 0; a < 2; ++a)
#pragma unroll
        for (int b = 0; b < 2; ++b)
#pragma unroll
            for (int m = 0; m < 4; ++m)
#pragma unroll
                for (int n = 0; n < 2; ++n) acc[a][b][m][n] = (f32x4){0.f, 0.f, 0.f, 0.f};
    bf16x8 At[4][2], B0[2][2], B1[2][2];
    const char* cA = (const char*)g.A + cur.abyte; const char* cB = (const char*)g.Bt + cur.bbyte;
    PG8_STAGE_B(PG8_SB(0, 0), cB); PG8_STAGE_B(PG8_SB(0, 1), cB + hstepB); PG8_STAGE(PG8_SA(0, 0), cA, oAc[0][0], oAc[0][1]); PG8_STAGE(PG8_SA(0, 1), cA, oAc[1][0], oAc[1][1]);
    if (wr == 1) PG8_BAR;
    PG8_WAIT_V(2); PG8_BAR;
    PG8_STAGE_B(PG8_SB(1, 0), cB + kstep); PG8_STAGE(PG8_SA(1, 0), cA + kstep, oAc[0][0], oAc[0][1]); PG8_STAGE_B(PG8_SB(1, 1), cB + hstepB + kstep);
    PG8_WAIT_V(6); PG8_BAR;
    for (;;) {
        bool has_nn = false;
        if (has_next) has_nn = S.next(ui + 2, nn);
        int tkp[2][2];
        if constexpr (GATHER) { if (has_nn) { PG8_TOK_LOAD(nn, tkp); } }
        const char* nA = has_next ? (const char*)g.A + nxt.abyte : cA; const char* nB = has_next ? (const char*)g.Bt + nxt.bbyte : cB;
        for (int t = 0; t < nt; t += 2) {
            const bool last = (t == nt - 2);
            const char* a1 = cA + (size_t)(t + 1) * kstep;
            const char* a2 = last ? nA : cA + (size_t)(t + 2) * kstep; const char* b2 = last ? nB : cB + (size_t)(t + 2) * kstep;
            const char* a3 = a2 + kstep; const char* b3 = b2 + kstep;
            unsigned o2[2][2];
#pragma unroll
            for (int h = 0; h < 2; ++h)
#pragma unroll
                for (int i = 0; i < 2; ++i) o2[h][i] = GATHER ? (last ? oAn[h][i] : oAc[h][i]) : oAc[h][i];
            PG8_LDB(B0, 0, 0); PG8_LDB(B1, 0, 1); PG8_SCHED; PG8_LDA(At, 0, 0); PG8_STAGE(PG8_SA(1, 1), a1, oAc[1][0], oAc[1][1]);
            PG8_WAIT_V(8); PG8_WAIT_L(0); PG8_BAR; PG8_MMA(0, 0, At, B0); PG8_MMA(0, 1, At, B1); PG8_BAR; PG8_SCHED;
            PG8_LDA(At, 0, 1); PG8_STAGE_B(PG8_SB(0, 0), b2); PG8_STAGE_B(PG8_SB(0, 1), b2 + hstepB); PG8_STAGE(PG8_SA(0, 0), a2, o2[0][0], o2[0][1]);
            PG8_WAIT_V(8); PG8_WAIT_L(0); PG8_BAR; PG8_MMA(1, 0, At, B0); PG8_MMA(1, 1, At, B1); PG8_BAR; PG8_SCHED;
            PG8_LDB(B0, 1, 0); PG8_LDB(B1, 1, 1); PG8_SCHED; PG8_LDA(At, 1, 0); PG8_STAGE(PG8_SA(0, 1), a2, o2[1][0], o2[1][1]);
            PG8_WAIT_V(8); PG8_WAIT_L(0); PG8_BAR; PG8_MMA(0, 0, At, B0); PG8_MMA(0, 1, At, B1); PG8_BAR; PG8_SCHED;
            PG8_LDA(At, 1, 1); PG8_STAGE_B(PG8_SB(1, 0), b3); PG8_STAGE_B(PG8_SB(1, 1), b3 + hstepB); PG8_STAGE(PG8_SA(1, 0), a3, o2[0][0], o2[0][1]);
            PG8_WAIT_V(8); PG8_WAIT_L(0); PG8_BAR; PG8_MMA(1, 0, At, B0); PG8_MMA(1, 1, At, B1); PG8_BAR; PG8_SCHED;
        }
        if constexpr (ALIGN_EPI) { if (wr == 0) PG8_BAR; }
        E(acc, cur, ctx);
        if (!has_next) break;
#pragma unroll
        for (int a = 0; a < 2; ++a)
#pragma unroll
            for (int b = 0; b < 2; ++b)
#pragma unroll
                for (int m = 0; m < 4; ++m)
#pragma unroll
                    for (int n = 0; n < 2; ++n) acc[a][b][m][n] = (f32x4){0.f, 0.f, 0.f, 0.f};
        cur = nxt; cA = nA; cB = nB; ++ui; nxt = nn; has_next = has_nn;
        if constexpr (GATHER) {
#pragma unroll
            for (int h = 0; h < 2; ++h)
#pragma unroll
                for (int i = 0; i < 2; ++i) oAc[h][i] = oAn[h][i];
            if (has_next) { PG8_TOK_OFF(tkp, oAn); }
        }
        if constexpr (ALIGN_EPI) { if (wr == 1) PG8_BAR; }
    }
    PG8_WAIT_V(0);
    if constexpr (!ALIGN_EPI) { if (wr == 0) PG8_BAR; }
    PG8_BAR;
#undef PG8_SA
#undef PG8_SB
#undef PG8_STAGE
#undef PG8_STAGE_B
#undef PG8_LDA
#undef PG8_LDB
#undef PG8_MMA
#undef PG8_WAIT_V
#undef PG8_WAIT_L
#undef PG8_BAR
#undef PG8_SCHED
#undef PG8_TOK_LOAD
#undef PG8_TOK_OFF
}
}
namespace attn_body {
using bf16=__hip_bfloat16;
using bf16x8=__attribute__((ext_vector_type(8)))short;
using s16x4=__attribute__((ext_vector_type(4)))short;
using f32x16=__attribute__((ext_vector_type(16)))float;
using u32x4=__attribute__((ext_vector_type(4)))unsigned;
constexpr int BATCH=16,NHEAD=16,SEQ=2048,D=64,DM=NHEAD*D;
constexpr int NW=8,QBLK=32,QB=QBLK*NW,KVBLK=64,NQB=SEQ/QB;
constexpr int ATTN_PITCH=DM, ATTN_UNIT_ROWS=QB;
__device__ __forceinline__ int crow(int r,int hi){return (r&3)+8*(r>>2)+4*hi;}
#define SBAR() __builtin_amdgcn_sched_barrier(0)
__device__ __forceinline__ void cmask(f32x16&p0,f32x16&p1,int jb,int qrel,int hi){
  const float NEG=-INFINITY; const int qd=qrel-64*jb-4*hi;
  #pragma unroll
  for(int r=0;r<16;++r){const int c=(r&3)+8*(r>>2); if(c>qd)p0[r]=NEG; if(c+32>qd)p1[r]=NEG;}
}

constexpr int NSLOT=3, SLOTB=8192;
constexpr int LDS_K=0, LDS_V=NSLOT*SLOTB, LDS_WS=2*NSLOT*SLOTB, LDS_OST=LDS_WS+NW*64*4, LDS_TAB=LDS_OST+NW*4096, LDS_BYTES=LDS_TAB+8192;
constexpr float C2=0.125f*1.4426950408889634f;
__device__ __forceinline__ void glds16(const void*gsrc,unsigned lds_dst){unsigned keep;
  asm volatile("s_mov_b32 %0, m0\n\ts_mov_b32 m0, %2\n\ts_nop 0\n\tglobal_load_lds_dwordx4 %1, off\n\ts_mov_b32 m0, %0":"=&s"(keep):"v"(gsrc),"s"(lds_dst):"memory");}
__device__ __forceinline__ float max3f(float a,float b,float c){float r;asm("v_max3_f32 %0, %1, %2, %3":"=v"(r):"v"(a),"v"(b),"v"(c));return r;}
__device__ __forceinline__ float max2f(float a,float b){float r;asm("v_max_f32_e32 %0, %1, %2":"=v"(r):"v"(a),"v"(b));return r;}
__device__ __forceinline__ float fadd_s(float a,float b){float r;asm("v_add_f32_e32 %0, %1, %2":"=v"(r):"v"(a),"v"(b));return r;}
__device__ __forceinline__ float fsub_s(float a,float b){float r;asm("v_sub_f32_e32 %0, %1, %2":"=v"(r):"v"(a),"v"(b));return r;}
typedef float f32x2_t __attribute__((ext_vector_type(2))); typedef float f32x4_t __attribute__((ext_vector_type(4))); typedef __bf16 bf16x2_t __attribute__((ext_vector_type(2)));
__device__ __forceinline__ unsigned cvtpk_s(float lo,float hi){f32x2_t v={lo,hi};bf16x2_t b=__builtin_convertvector(v,bf16x2_t);return __builtin_bit_cast(unsigned,b);}
#define WAIT_BAR(N) asm volatile("s_waitcnt vmcnt(" #N ") lgkmcnt(0)\n\ts_barrier":::"memory")

__device__ __forceinline__ void qkt(f32x16&p0,f32x16&p1,const char*Kslot,const bf16x8*qr,int r32,int hi){
  const char*kb=Kslot+hi*1024+r32*16;
  #pragma unroll
  for(int d0=0;d0<4;++d0){
    const bf16x8 b0=*reinterpret_cast<const bf16x8*>(kb+d0*2048);
    const bf16x8 b1=*reinterpret_cast<const bf16x8*>(kb+d0*2048+512);
    {p0=__builtin_amdgcn_mfma_f32_32x32x16_bf16(b0,qr[d0],p0,0,0,0);p1=__builtin_amdgcn_mfma_f32_32x32x16_bf16(b1,qr[d0],p1,0,0,0);}}
}
typedef __attribute__((address_space(3))) const char* lds_cptr;
typedef short v4i16_t __attribute__((ext_vector_type(4)));
__device__ __forceinline__ void kload8(bf16x8*kf,lds_cptr kp){
  kf[0]=*(const __attribute__((address_space(3))) bf16x8*)(kp);      kf[1]=*(const __attribute__((address_space(3))) bf16x8*)(kp+512);
  kf[2]=*(const __attribute__((address_space(3))) bf16x8*)(kp+2048); kf[3]=*(const __attribute__((address_space(3))) bf16x8*)(kp+2560);
  kf[4]=*(const __attribute__((address_space(3))) bf16x8*)(kp+4096); kf[5]=*(const __attribute__((address_space(3))) bf16x8*)(kp+4608);
  kf[6]=*(const __attribute__((address_space(3))) bf16x8*)(kp+6144); kf[7]=*(const __attribute__((address_space(3))) bf16x8*)(kp+6656);
}
__device__ __forceinline__ void kload2(bf16x8*kf,lds_cptr kp,int j){ kf[2*j]=*(const __attribute__((address_space(3))) bf16x8*)(kp+j*2048); kf[2*j+1]=*(const __attribute__((address_space(3))) bf16x8*)(kp+j*2048+512); }
__device__ __forceinline__ s16x4 vtr(lds_cptr p){ return __builtin_bit_cast(s16x4,__builtin_amdgcn_ds_read_tr16_b64_v4i16((__attribute__((address_space(3))) v4i16_t*)p)); }
__device__ __forceinline__ float rowmax(const f32x16&p0,const f32x16&p1){
  float a=max3f(p0[0],p0[1],p1[0]),b=max3f(p0[2],p0[3],p1[1]);a=max3f(a,p1[2],p1[3]);
  #pragma unroll
  for(int r=4;r<16;r+=4){a=max3f(a,p0[r],p0[r+1]);b=max3f(b,p0[r+2],p0[r+3]);a=max3f(a,p1[r],p1[r+1]);b=max3f(b,p1[r+2],p1[r+3]);}
  const float m=max2f(a,b);
  auto rr=__builtin_amdgcn_permlane32_swap(__float_as_uint(m),__float_as_uint(m),false,false);
  return max2f(__uint_as_float(rr[0]),__uint_as_float(rr[1]));
}
__device__ __forceinline__ void pv(f32x16*o,int vb,bf16x8 pa0,bf16x8 pa1,bf16x8 pa2,bf16x8 pa3){
  #pragma unroll
  for(int d0=0;d0<2;++d0){s16x4 lo[4],hi[4];
    #pragma unroll
    for(int ks=0;ks<4;++ks){
      asm volatile("ds_read_b64_tr_b16 %0,%1 offset:%c2":"=&v"(lo[ks]):"v"(vb),"i"(d0*4096+ks*1024):"memory");
      asm volatile("ds_read_b64_tr_b16 %0,%1 offset:%c2":"=&v"(hi[ks]):"v"(vb),"i"(d0*4096+ks*1024+512):"memory");}
    asm volatile("s_waitcnt lgkmcnt(0)":::"memory");SBAR();
    #define PK(k) (bf16x8){lo[k][0],lo[k][1],lo[k][2],lo[k][3],hi[k][0],hi[k][1],hi[k][2],hi[k][3]}
    o[d0]=__builtin_amdgcn_mfma_f32_32x32x16_bf16(pa0,PK(0),o[d0],0,0,0);
    o[d0]=__builtin_amdgcn_mfma_f32_32x32x16_bf16(pa1,PK(1),o[d0],0,0,0);
    o[d0]=__builtin_amdgcn_mfma_f32_32x32x16_bf16(pa2,PK(2),o[d0],0,0,0);
    o[d0]=__builtin_amdgcn_mfma_f32_32x32x16_bf16(pa3,PK(3),o[d0],0,0,0);
    #undef PK
  }
}

#ifndef ATTN_STORE16
#define ATTN_STORE16(p,v) (*(u32x4*)(p)=(v))
#endif
struct AttnExtra { const float* kbias; const float* kpart; const float* relb; };
template<int THRL,int MODE> __device__ __forceinline__ void attn_unit(int b,int h,int qb,const bf16*Q,const bf16*__restrict__ K,const bf16*__restrict__ V,bf16*O,char*shm,const AttnExtra&X,const int tid){
  const int lane=tid&63,r32=lane&31,hi=lane>>5; const int wid=__builtin_amdgcn_readfirstlane(tid>>6);
  const long rowbase=(long)b*SEQ; const int q0=qb*QB;
  const bf16*Qw=Q+(rowbase+q0+wid*QBLK)*DM+h*D;
  const bf16*Kh=K+rowbase*DM+h*D,*Vh=V+rowbase*DM+h*D;
  const unsigned lds0=(unsigned)(uintptr_t)shm;
  float*wsf=(float*)(shm+LDS_WS)+wid*64;
  const bf16*ksrc=Kh+(long)lane*DM+wid*8;
  const bf16*vsrc=Vh+(long)(16*(wid&3)+(lane>>2))*DM+(wid>>2)*32+(lane&3)*8;
  const unsigned kdst=lds0+LDS_K+wid*1024, vdst=lds0+LDS_V+wid*1024;
  #define DMA_K(t,slot) glds16(ksrc+(long)(t)*KVBLK*DM,(unsigned)__builtin_amdgcn_readfirstlane(kdst+(slot)))
  #define DMA_V(t,slot) glds16(vsrc+(long)(t)*KVBLK*DM,(unsigned)__builtin_amdgcn_readfirstlane(vdst+(slot)))
  const int vb0=(int)(lds0+LDS_V)+((lane>>4)&1)*32+(lane&3)*8+(4*hi+((lane&15)>>2))*64;
  const char*Kbase=shm+LDS_K; bf16x8 kf[8];
  const lds_cptr shm3=(lds_cptr)shm; const lds_cptr kp0=shm3+LDS_K+hi*1024+r32*16; const lds_cptr vp0=shm3+LDS_V+((lane>>4)&1)*32+(lane&3)*8+(4*hi+((lane&15)>>2))*64;
  const int NT=(q0+QB)/KVBLK;
  const lds_cptr tab3=(lds_cptr)shm+LDS_TAB;
  { int tq_=tid; asm volatile("":"+v"(tq_)); __attribute__((address_space(3))) float* tabw=(__attribute__((address_space(3))) float*)((__attribute__((address_space(3))) char*)shm+LDS_TAB);
    if(MODE==0){ const f32x4_t kv=*reinterpret_cast<const f32x4_t*>(X.kbias+tq_*4); *reinterpret_cast<__attribute__((address_space(3))) f32x4_t*>(tabw+tq_*4)=kv; }
    else{ const int hm=h-8; { const int j=tq_>>6,d=tq_&63; const float*kp=X.kpart+(long)((b*8+j)*2)*512+hm*64+d; tabw[j*64+d]=(kp[0]+kp[512])*(1.0f/256.0f); }
      { const int tv=tq_; const int n=tv-256; float val=0.f;
        if(n>=0&&n<113){ int bk=n; if(n>=16){ bk=16+(n>=19)+(n>=21)+(n>=24)+(n>=27)+(n>=31)+(n>=35)+(n>=40)+(n>=46)+(n>=52)+(n>=59)+(n>=67)+(n>=77)+(n>=87)+(n>=99); }
          val=(X.relb[bk*8+hm]-X.relb[31*8+hm])*1.4426950408889634f; }
        tabw[512+tv]=val; } } }
  DMA_K(0,0);DMA_V(0,0);DMA_K(1,SLOTB);
  bf16x8 qr[4];
  { int lq_=lane; asm volatile("":"+v"(lq_)); const int rq_=lq_&31,hq_=lq_>>5;
  #pragma unroll
  for(int d0=0;d0<4;++d0)qr[d0]=*reinterpret_cast<const bf16x8*>(&Qw[(long)rq_*DM+d0*16+hq_*8]); }
  float mhat=0.f,l_reg=0.f;f32x16 o[2];o[0]=f32x16{};o[1]=f32x16{};
  const int qrel=wid*QBLK+r32;
  unsigned selmask=0u;
  #define CINIT(C0,C1,t) do{ const int t_=(t); \
    if(MODE==0){ const lds_cptr kbp_=tab3+(64*t_+4*hi)*4; \
      _Pragma("unroll") for(int j_=0;j_<4;++j_){ const f32x4_t a_=*(const __attribute__((address_space(3))) f32x4_t*)(kbp_+32*j_); const f32x4_t b_=*(const __attribute__((address_space(3))) f32x4_t*)(kbp_+128+32*j_); \
        _Pragma("unroll") for(int i_=0;i_<4;++i_){ C0[4*j_+i_]=a_[i_]-mhat; C1[4*j_+i_]=b_[i_]-mhat; } } } \
    else{ const int blk_=t_>>2; const bool keep_=(blk_>=qb)||(((selmask>>blk_)&1u)!=0u); const float c_=keep_?-mhat:-INFINITY; \
      _Pragma("unroll") for(int r_=0;r_<16;++r_){C0[r_]=c_;C1[r_]=c_;} } }while(0)
  #define TMASK(P0,P1,t) do{ const int t_=(t); \
    if(MODE==1){ \
      if(64*t_+176>q0+32*wid){ const int db_=(q0-64*t_)+qrel-4*hi; \
        const lds_cptr tbp_=tab3+2048+4*(db_+256-63); \
        _Pragma("unroll") for(int r_=0;r_<16;++r_){ const int ko_=(r_&3)+8*(r_>>2); \
          P0[r_]+=*(const __attribute__((address_space(3))) float*)(tbp_+4*(63-ko_)); P1[r_]+=*(const __attribute__((address_space(3))) float*)(tbp_+4*(31-ko_)); } } } \
    { const int jb_=t_-(NT-4); if(jb_>=0)cmask(P0,P1,jb_,qrel,hi); } }while(0)
  #define CMASK(P0,P1,t) TMASK(P0,P1,t)
  bool resc=false;
  #define START(P0,P1) do{ const float rm=rowmax(P0,P1); resc=false; \
    { const float dl=(rm>-INFINITY)?rm:0.f; mhat=fadd_s(mhat,dl); \
      _Pragma("unroll") for(int r=0;r<16;++r){P0[r]=fsub_s(P0[r],dl);P1[r]=fsub_s(P1[r],dl);} \
    } \
    _Pragma("unroll") for(int r=0;r<16;++r)P0[r]=__builtin_amdgcn_exp2f(P0[r]); }while(0)
  #define RESC() do{ if(resc){ asm volatile("s_waitcnt lgkmcnt(0)":::"memory"); \
      _Pragma("unroll") for(int d_=0;d_<2;++d_) _Pragma("unroll") for(int r=0;r<16;++r)o[d_][r]*=wsf[crow(r,hi)]; } }while(0)
  f32x16 pA0,pA1,pB0,pB1;
  int sl_prev=0,sl_cur=0,sl_next=SLOTB;
  #define ROT() do{sl_prev=sl_cur;sl_cur=sl_next;sl_next=(sl_next==(NSLOT-1)*SLOTB)?0:sl_next+SLOTB;}while(0)
  DMA_K(2,2*SLOTB);
  WAIT_BAR(3);
  if(MODE==1){
    float gt[7];
    #pragma unroll
    for(int j=0;j<7;++j){ float s=0.f;
      #pragma unroll
      for(int d0=0;d0<4;++d0){ const f32x4_t ka=*(const __attribute__((address_space(3))) f32x4_t*)(tab3+(j*64+16*d0+8*hi)*4); const f32x4_t kb2=*(const __attribute__((address_space(3))) f32x4_t*)(tab3+(j*64+16*d0+8*hi+4)*4);
        #pragma unroll
        for(int i=0;i<4;++i){ s+=__uint_as_float(((unsigned)(unsigned short)qr[d0][i])<<16)*ka[i]; s+=__uint_as_float(((unsigned)(unsigned short)qr[d0][4+i])<<16)*kb2[i]; } }
      auto rr=__builtin_amdgcn_permlane32_swap(__float_as_uint(s),__float_as_uint(s),false,false); s=__uint_as_float(rr[0])+__uint_as_float(rr[1]);
      gt[j]=(j<qb)?s:-INFINITY; }
    #pragma unroll
    for(int j=0;j<7;++j){ int rk=0;
      #pragma unroll
      for(int k=0;k<7;++k){ if(k!=j){ rk+=(gt[k]>gt[j]||(gt[k]==gt[j]&&k<j))?1:0; } }
      if(j<qb&&rk<3)selmask|=(1u<<j); } }
  CINIT(pA0,pA1,0); qkt(pA0,pA1,Kbase,qr,r32,hi);asm volatile("s_nop 15\n\ts_nop 7":"+v"(pA0),"+v"(pA1));CMASK(pA0,pA1,0);
  START(pA0,pA1);
  _Pragma("unroll") for(int r=0;r<16;++r)pA1[r]=__builtin_amdgcn_exp2f(pA1[r]);
  WAIT_BAR(0);
  DMA_K(3,0);DMA_V(1,SLOTB);
  ROT();
  kload8(kf,kp0+sl_cur);
  WAIT_BAR(2);
  s16x4 vlo[8],vhi[8]; u32x4 pw0,pw1,pw2,pw3;
  #define PKW(P,B) cvtpk_s(P[B],P[B+1])
  #define PAF(k) __builtin_bit_cast(bf16x8,pw##k)
  #define VFR(i) (bf16x8){vlo[i][0],vlo[i][1],vlo[i][2],vlo[i][3],vhi[i][0],vhi[i][1],vhi[i][2],vhi[i][3]}
  #define PIN(x) asm volatile("":"+v"(x))
  #define MX3(a,b,c) __builtin_fmaxf(__builtin_fmaxf((a),(b)),(c))
  #define GAPA(MF,A0,A1,A2,A3,W0,W1,PW) do{ MF; sacc+=A0; sacc+=A1; sacc+=A2; sacc+=A3; PIN(sacc); W0; W1; PIN(PW); SBAR(); }while(0)
  #define EX(v) __builtin_amdgcn_exp2f(v)
  #define GAPB(MF,X,B) do{ MF; X[B]=EX(X[B]); X[B+1]=EX(X[B+1]); X[B+2]=EX(X[B+2]); X[B+3]=EX(X[B+3]); PIN(X); SBAR(); }while(0)
  #define VRD(i) do{ vlo[i]=vtr(vp_+(((i)>>2)*4096+((i)&3)*1024)); vhi[i]=vtr(vp_+(((i)>>2)*4096+((i)&3)*1024+512)); }while(0)
  #define KRD(G,j) do{ if(G){ kload2(kf,kp0+sl_next,j); SBAR(); } }while(0)
  #define STEP(C0,C1,P0,P1,t,GK,GV,GL) do{ SBAR(); CINIT(C0,C1,t); SBAR(); \
    const lds_cptr vp_=vp0+sl_prev; \
    VRD(0); SBAR(); float sacc=(P0[0]+P0[1]); \
    GAPA(C0=__builtin_amdgcn_mfma_f32_32x32x16_bf16(kf[0],qr[0],C0,0,0,0), P0[2],P0[3],P0[4],P0[5],     pw0[0]=PKW(P0,0), pw0[1]=PKW(P0,2), pw0); \
    VRD(4); SBAR(); GAPA(C1=__builtin_amdgcn_mfma_f32_32x32x16_bf16(kf[1],qr[0],C1,0,0,0), P0[6],P0[7],P0[8],P0[9],     pw0[2]=PKW(P0,4), pw0[3]=PKW(P0,6), pw0); \
    VRD(1); SBAR(); GAPA(C0=__builtin_amdgcn_mfma_f32_32x32x16_bf16(kf[2],qr[1],C0,0,0,0),   P0[10],P0[11],P0[12],P0[13], pw1[0]=PKW(P0,8), pw1[1]=PKW(P0,10), pw1); \
    VRD(5); SBAR(); GAPA(C1=__builtin_amdgcn_mfma_f32_32x32x16_bf16(kf[3],qr[1],C1,0,0,0),   P0[14],P0[15],P1[0],P1[1],   pw1[2]=PKW(P0,12),pw1[3]=PKW(P0,14), pw1); \
    VRD(2); SBAR(); GAPA(C0=__builtin_amdgcn_mfma_f32_32x32x16_bf16(kf[4],qr[2],C0,0,0,0),   P1[2],P1[3],P1[4],P1[5],     pw2[0]=PKW(P1,0), pw2[1]=PKW(P1,2), pw2); \
    VRD(6); SBAR(); GAPA(C1=__builtin_amdgcn_mfma_f32_32x32x16_bf16(kf[5],qr[2],C1,0,0,0),   P1[6],P1[7],P1[8],P1[9],     pw2[2]=PKW(P1,4), pw2[3]=PKW(P1,6), pw2); \
    VRD(3); SBAR(); GAPA(C0=__builtin_amdgcn_mfma_f32_32x32x16_bf16(kf[6],qr[3],C0,0,0,0),   P1[10],P1[11],P1[12],P1[13], pw3[0]=PKW(P1,8), pw3[1]=PKW(P1,10), pw3); \
    VRD(7); SBAR(); GAPA(C1=__builtin_amdgcn_mfma_f32_32x32x16_bf16(kf[7],qr[3],C1,0,0,0),   P1[14],P1[15],0.f,0.f,       pw3[2]=PKW(P1,12),pw3[3]=PKW(P1,14), pw3); \
    l_reg+=sacc; \
    if(GK){DMA_K((t)+3,sl_cur);} if(GV){DMA_V((t)+1,sl_next);} \
    CMASK(C0,C1,t); \
    { float a=MX3(C0[0],C0[1],C1[0]),b=MX3(C0[2],C0[3],C1[1]); a=MX3(a,C1[2],C1[3]); \
      _Pragma("unroll") for(int r=4;r<16;r+=4){a=MX3(a,C0[r],C0[r+1]);b=MX3(b,C0[r+2],C0[r+3]);a=MX3(a,C1[r],C1[r+1]);b=MX3(b,C1[r+2],C1[r+3]);} \
      float rm=__builtin_fmaxf(a,b); { auto rr=__builtin_amdgcn_permlane32_swap(__float_as_uint(rm),__float_as_uint(rm),false,false); rm=__builtin_fmaxf(__uint_as_float(rr[0]),__uint_as_float(rr[1])); } \
      resc=false; \
      if(__builtin_expect(__any(rm>(float)THRL),0)){ const float dl=__builtin_fmaxf(rm,0.f); mhat+=dl; \
        _Pragma("unroll") for(int r=0;r<16;++r){C0[r]-=dl;C1[r]-=dl;} \
        const float f=__builtin_amdgcn_exp2f(-dl); l_reg*=f; if(hi==0)wsf[r32]=f; resc=true; } } \
    SBAR(); \
    GAPB(o[0]=__builtin_amdgcn_mfma_f32_32x32x16_bf16(PAF(0),VFR(0),o[0],0,0,0), C0,0); \
    GAPB(o[1]=__builtin_amdgcn_mfma_f32_32x32x16_bf16(PAF(0),VFR(4),o[1],0,0,0), C0,4); \
    KRD(GL,0); GAPB(o[0]=__builtin_amdgcn_mfma_f32_32x32x16_bf16(PAF(1),VFR(1),o[0],0,0,0), C0,8); \
    KRD(GL,1); GAPB(o[1]=__builtin_amdgcn_mfma_f32_32x32x16_bf16(PAF(1),VFR(5),o[1],0,0,0), C0,12); \
    KRD(GL,2); GAPB(o[0]=__builtin_amdgcn_mfma_f32_32x32x16_bf16(PAF(2),VFR(2),o[0],0,0,0), C1,0); \
    KRD(GL,3); GAPB(o[1]=__builtin_amdgcn_mfma_f32_32x32x16_bf16(PAF(2),VFR(6),o[1],0,0,0), C1,4); \
    GAPB(o[0]=__builtin_amdgcn_mfma_f32_32x32x16_bf16(PAF(3),VFR(3),o[0],0,0,0), C1,8); \
    GAPB(o[1]=__builtin_amdgcn_mfma_f32_32x32x16_bf16(PAF(3),VFR(7),o[1],0,0,0), C1,12); \
    }while(0)
  int t=1;
  for(;t+5<NT;t+=2){
    STEP(pB0,pB1,pA0,pA1,t,true,true,true);     WAIT_BAR(2); RESC(); ROT();
    STEP(pA0,pA1,pB0,pB1,t+1,true,true,true);   WAIT_BAR(2); RESC(); ROT();
  }
  #define ENDW(tt) do{ if((tt)+3<NT){WAIT_BAR(2);} else if((tt)+2<NT){WAIT_BAR(1);} else {WAIT_BAR(0);} }while(0)
  for(;t+1<NT;t+=2){
    STEP(pB0,pB1,pA0,pA1,t,(t+3<NT),(t+1<NT),(t+1<NT));       ENDW(t);   RESC(); ROT();
    STEP(pA0,pA1,pB0,pB1,t+1,(t+4<NT),(t+2<NT),(t+2<NT));     ENDW(t+1); RESC(); ROT();
  }
  STEP(pB0,pB1,pA0,pA1,NT-1,false,false,false); RESC();
  { float sacc=pB0[0]+pB0[1]; _Pragma("unroll") for(int r=2;r<16;++r)sacc+=pB0[r]; _Pragma("unroll") for(int r=0;r<16;++r)sacc+=pB1[r]; l_reg+=sacc;
    pw0=(u32x4){PKW(pB0,0),PKW(pB0,2),PKW(pB0,4),PKW(pB0,6)};pw1=(u32x4){PKW(pB0,8),PKW(pB0,10),PKW(pB0,12),PKW(pB0,14)};pw2=(u32x4){PKW(pB1,0),PKW(pB1,2),PKW(pB1,4),PKW(pB1,6)};pw3=(u32x4){PKW(pB1,8),PKW(pB1,10),PKW(pB1,12),PKW(pB1,14)};
    SBAR(); pv(o,vb0+sl_cur,PAF(0),PAF(1),PAF(2),PAF(3)); }
  #undef PKW
  #undef PAF
  #undef VFR
  #undef PIN
  #undef MX3
  #undef GAPA
  #undef GAPB
  #undef EX
  #undef VRD
  #undef KRD
  #undef STEP
  #undef ENDW
  {auto rr=__builtin_amdgcn_permlane32_swap(__float_as_uint(l_reg),__float_as_uint(l_reg),false,false);l_reg=__uint_as_float(rr[0])+__uint_as_float(rr[1]);}
  if(hi==0)wsf[32+r32]=l_reg;asm volatile("s_waitcnt lgkmcnt(0)":::"memory");
  float rli[16];
  #pragma unroll
  for(int r=0;r<16;++r)rli[r]=__builtin_amdgcn_rcpf(wsf[32+crow(r,hi)]);
  bf16*Ow=O+(rowbase+q0+wid*QBLK)*DM+h*D;
  { bf16*stg=(bf16*)(shm+LDS_OST)+wid*2048;
    #pragma unroll
    for(int r=0;r<16;++r){const int orow=crow(r,hi);
      #pragma unroll
      for(int d0=0;d0<2;++d0)stg[orow*64+d0*32+r32]=__float2bfloat16(o[d0][r]*rli[r]);}
    asm volatile("s_waitcnt lgkmcnt(0)":::"memory");
    int lv_=lane; asm volatile("":"+v"(lv_));
    #pragma unroll
    for(int i=0;i<4;++i){const int row=i*8+(lv_>>3),ch=lv_&7; const u32x4 v=*(const u32x4*)(stg+row*64+ch*8); ATTN_STORE16(Ow+(long)row*DM+ch*8,v);} }
  asm volatile("s_waitcnt lgkmcnt(0)\n\ts_barrier":::"memory");
  #undef DMA_K
  #undef DMA_V
  #undef CMASK
  #undef TMASK
  #undef CINIT
  #undef START
  #undef RESC
  #undef ROT
}
constexpr int ATTN_LDS_BYTES=LDS_BYTES;
struct AttnTensors { const bf16* Q; const bf16* K; const bf16* V; bf16* O; };
struct AttnUnit { int b, h, qb; };
struct StaticOrder {
  int vcu, G;
  __device__ __forceinline__ explicit StaticOrder(int grid,int vcu_):vcu(vcu_),G(grid){}
  __device__ __forceinline__ bool next(int i,AttnUnit&u)const{ const int L=i*G+vcu; if(L>=2048)return false; const int v=L&255,k=L>>8,s=v>>1; const int moba=(k>>2)&1; const int setA=((v&1)^moba);
    const int kk=k&3; const int qa=(kk==0)?0:(kk==1)?3:(kk==2)?4:7, qb2=(kk==0)?1:(kk==1)?2:(kk==2)?5:6;
    u.b=s>>3; u.h=(s&7)+8*moba; u.qb=setA?qb2:qa; return true; }
};
template<class Sched,int THRL=8> __device__ __forceinline__ void attn_phase(int tid,char*lds,const AttnTensors&T,const Sched&S,const float*kbias,const float*kpart,const float*relb){
  AttnUnit u;
  for(int i=0;S.next(i,u);++i){ AttnExtra X; X.kbias=kbias+(long)(u.b*8+(u.h&7))*SEQ; X.kpart=kpart; X.relb=relb;
#if !defined(ATT_ONLY) || ATT_ONLY==0
    if(u.h<8) attn_unit<THRL,0>(u.b,u.h,u.qb,T.Q,T.K,T.V,T.O,lds,X,tid);
#endif
#if !defined(ATT_ONLY) || ATT_ONLY==1
    if(u.h>=8) attn_unit<THRL,1>(u.b,u.h,u.qb,T.Q,T.K,T.V,T.O,lds,X,tid);
#endif
  }
}
#undef SBAR
#undef WAIT_BAR
}
#define XB_TMO      128
#define XB_XCNT(j)  (256  + 64 * (j))
#define XB_XSUB(j)  (1280 + 64 * (j))
#define XB_XGEN(j)  (2304 + 64 * (j))
#define XB_TOP      3328
#define XB_TOPGEN   3392
#define XCD_BAR_WORDS 3456
#define XB_SPIN_CAP (1u << 18)

__device__ __forceinline__ unsigned xb_ld(unsigned* p)              { return __hip_atomic_load(p, __ATOMIC_RELAXED, __HIP_MEMORY_SCOPE_AGENT); }
__device__ __forceinline__ unsigned xb_add(unsigned* p, unsigned v) { return __hip_atomic_fetch_add(p, v, __ATOMIC_RELAXED, __HIP_MEMORY_SCOPE_AGENT); }
__device__ __forceinline__ unsigned xb_xcc_id() { return (unsigned)__builtin_amdgcn_s_getreg((3 << 11) | 20) & 0xFu; }
#define XB_SPIN(cond, bar) do { unsigned _sp = 0; while (cond) { __builtin_amdgcn_s_sleep(1); \
    if ((++_sp & 255u) == 0u) { if (xb_ld(&(bar)[XB_TMO])) break; if (_sp > XB_SPIN_CAP) { atomicAdd(&(bar)[XB_TMO], 1u); break; } } } } while (0)

struct XcdBarrier {
    unsigned* bar; unsigned x;
    volatile LAS unsigned* st;
};

__device__ __forceinline__ XcdBarrier xcd_barrier_post(unsigned* bar, volatile LAS unsigned* st) {
    XcdBarrier b; b.bar = bar; b.x = xb_xcc_id(); b.st = st;
    if (threadIdx.x == 0) (void)xb_add(&bar[XB_XCNT(b.x)], 1u);
    return b;
}
__device__ __forceinline__ void xcd_barrier_complete(unsigned* bar, unsigned x, unsigned& nloc, unsigned& nx) {
    const unsigned G = gridDim.x * gridDim.y * gridDim.z;
    unsigned sum, cnt, mine, sp = 0u;
    for (;;) {
        sum = 0u; cnt = 0u; mine = 0u;
#pragma unroll
        for (unsigned j = 0; j < 16; ++j) { const unsigned c = xb_ld(&bar[XB_XCNT(j)]); sum += c; cnt += (c > 0u) ? 1u : 0u; mine = (j == x) ? c : mine; }
        if (sum == G) break;
        __builtin_amdgcn_s_sleep(1);
        if ((++sp & 255u) == 0u) { if (xb_ld(&bar[XB_TMO])) break; if (sp > XB_SPIN_CAP) { atomicAdd(&bar[XB_TMO], 1u); break; } }
    }
    nloc = mine > 0u ? mine : 1u; nx = cnt > 0u ? cnt : 1u;
}

__device__ __forceinline__ void xcd_barrier(const XcdBarrier& b) {
    asm volatile("s_waitcnt vmcnt(0)" ::: "memory");
    __syncthreads();
    if (threadIdx.x == 0) {
        unsigned* bar = b.bar;
        __builtin_amdgcn_s_waitcnt(0);
        unsigned nloc = b.st[0], nx = b.st[1];
        if (nloc == 0u) { xcd_barrier_complete(bar, b.x, nloc, nx); b.st[0] = nloc; b.st[1] = nx; }
        const unsigned old = xb_add(&bar[XB_XSUB(b.x)], 1u);
        const unsigned gen = old / nloc;
        if (old + 1u == (gen + 1u) * nloc) {
            __builtin_amdgcn_fence(__ATOMIC_RELEASE, "agent");
            asm volatile("s_waitcnt vmcnt(0)" ::: "memory");
            const unsigned og = xb_add(&bar[XB_TOP], 1u);
            const unsigned tg = og / nx;
            if (og + 1u == (tg + 1u) * nx) xb_add(&bar[XB_TOPGEN], 1u);
            else XB_SPIN(xb_ld(&bar[XB_TOPGEN]) == tg, bar);
            __builtin_amdgcn_fence(__ATOMIC_ACQUIRE, "agent");
            xb_add(&bar[XB_XGEN(b.x)], 1u);
            asm volatile("s_waitcnt vmcnt(0)" ::: "memory");
        } else {
            XB_SPIN(xb_ld(&bar[XB_XGEN(b.x)]) == gen, bar);
            __builtin_amdgcn_fence(__ATOMIC_ACQUIRE, "agent");
            asm volatile("s_waitcnt vmcnt(0)" ::: "memory");
        }
    }
    __syncthreads();
}
constexpr int NWAVES = 8;
#define LDS_WAIT() asm volatile("s_waitcnt lgkmcnt(0)" ::: "memory")
#define VM_WAIT() asm volatile("s_waitcnt vmcnt(0)" ::: "memory")
__device__ __forceinline__ float wave_sum(float v) {
#pragma unroll
    for (int o = 1; o < 64; o <<= 1) v += __shfl_xor(v, o);
    return v;
}
__device__ __forceinline__ void row_load(const float* p, int lane, f32x4 (&v)[4]) {
    const GAS f32x4* xr = (const GAS f32x4*)p + lane;
#pragma unroll
    for (int j = 0; j < 4; ++j) v[j] = xr[64 * j];
}
__device__ __forceinline__ void row_store_f32(float* p, int lane, const f32x4 (&v)[4]) {
    GAS f32x4* o = (GAS f32x4*)p + lane;
#pragma unroll
    for (int j = 0; j < 4; ++j) o[64 * j] = v[j];
}
__device__ __forceinline__ void row_store_bf16(bf16_t* p, int lane, const f32x4 (&v)[4]) {
    GAS u32x2* o = (GAS u32x2*)p + lane;
#pragma unroll
    for (int j = 0; j < 4; ++j) { u32x2 w; w.x = cvt_pk_bf16(v[j][0], v[j][1]); w.y = cvt_pk_bf16(v[j][2], v[j][3]); o[64 * j] = w; }
}
__device__ __forceinline__ void row_layernorm(f32x4 (&v)[4], const f32x4 (&g)[4], const f32x4 (&b)[4]) {
    float s = 0.f;
#pragma unroll
    for (int j = 0; j < 4; ++j) s += (v[j][0] + v[j][1]) + (v[j][2] + v[j][3]);
    const float mean = wave_sum(s) * (1.f / DM); float s2 = 0.f;
#pragma unroll
    for (int j = 0; j < 4; ++j) { v[j] = v[j] - mean; s2 += (v[j][0] * v[j][0] + v[j][1] * v[j][1]) + (v[j][2] * v[j][2] + v[j][3] * v[j][3]); }
    const float rstd = 1.f / sqrtf(wave_sum(s2) * (1.f / DM) + LN_EPS);
#pragma unroll
    for (int j = 0; j < 4; ++j) v[j] = v[j] * rstd * g[j] + b[j];
}
template <int H, int MASK, int N> __device__ __forceinline__ void bfly_step(float (&v)[N], int lane) {
    const bool up = (lane & MASK) != 0;
#pragma unroll
    for (int i = 0; i < H; ++i) { const float a = v[i], b = v[i + H]; const float send = up ? a : b, keep = up ? b : a; v[i] = keep + __shfl_xor(send, MASK); }
}
__device__ __forceinline__ void butterfly64(float (&v)[64], int lane) { bfly_step<32, 32>(v, lane); bfly_step<16, 16>(v, lane); bfly_step<8, 8>(v, lane); bfly_step<4, 4>(v, lane); bfly_step<2, 2>(v, lane); bfly_step<1, 1>(v, lane); }
__device__ __forceinline__ void butterfly32(float (&v)[32], int lane) { bfly_step<16, 32>(v, lane); bfly_step<8, 16>(v, lane); bfly_step<4, 8>(v, lane); bfly_step<2, 4>(v, lane); bfly_step<1, 2>(v, lane); v[0] += __shfl_xor(v[0], 1); }
template <int E> __device__ __forceinline__ void thin_dot(const f32x4 (&xn)[4][4], const LAS float* w, int ws, int lane, float (&acc)[4 * E]) {
#pragma unroll
    for (int i = 0; i < 4 * E; ++i) acc[i] = 0.f;
#pragma unroll
    for (int e = 0; e < E; ++e)
#pragma unroll
        for (int j = 0; j < 4; ++j) { const f32x4 wv = *(const LAS f32x4*)(w + e * ws + 4 * lane + 256 * j);
#pragma unroll
            for (int r = 0; r < 4; ++r) { float a = acc[r * E + e]; a = fmaf(xn[r][j][0], wv[0], a); a = fmaf(xn[r][j][1], wv[1], a); a = fmaf(xn[r][j][2], wv[2], a); a = fmaf(xn[r][j][3], wv[3], a); acc[r * E + e] = a; } }
}
__device__ __forceinline__ float log_sigmoid(float z) { const float a = fabsf(z); return fminf(z, 0.f) - log1pf(__expf(-a)); }

__device__ __forceinline__ void forget_rows(const f32x4 (&xn)[4][4], const LAS float* wf, const float* bf, float* logf, int t0, int lane) {
    float acc[32]; thin_dot<8>(xn, wf, 1024, lane, acc); butterfly32(acc, lane);
    const int r = lane >> 4, h = (lane >> 1) & 7, t = t0 + r;
    if ((lane & 1) == 0) logf[(size_t)((t >> 11) * 8 + h) * SEQ + (t & (SEQ - 1))] = log_sigmoid(acc[0] + bf[h]);
}
__device__ __forceinline__ void load_wf(const float* w_in_l, LAS float* wf, int tid) {
    for (int idx = tid; idx < 8192; idx += NWAVES * 64) { const int k = idx >> 3, h = idx & 7; wf[h * 1024 + k] = w_in_l[(size_t)k * IN_COLS + FCOL + h]; }
}

template <int MAPK> __device__ __forceinline__ int wt_map(int n) {
    if (MAPK == 0) return n;
    if (MAPK == 1) return n < FCOL ? n : (n < FCOL + 8 ? -1 : n - 8);
    return ((n & 1023) >> 7) * 256 + (n >> 10) * 128 + (n & 127);
}
constexpr int TR_TILE_BYTES = 64 * 65 * 4;
template <int MAPK> __device__ __forceinline__ void transpose_item(const float* W, int K, int N, bf16_t* WT, LAS float* scr, int item, int lane) {
    const int nblk = (N + 63) / 64, kb = item / nblk, nb = item % nblk, k0 = 64 * kb, n0 = 64 * nb;
    const int n4 = (lane & 15) * 4, kr = lane >> 4;
    const bool ok = (n0 + n4) < N;
    const GAS f32x4* src = (const GAS f32x4*)(W + (size_t)(k0 + kr) * N + n0 + n4);
    f32x4 v[16];
#pragma unroll
    for (int i = 0; i < 16; ++i) v[i] = ok ? src[(size_t)i * N] : (f32x4){0.f, 0.f, 0.f, 0.f};
#pragma unroll
    for (int i = 0; i < 16; ++i) { const int k = 4 * i + kr; scr[(n4 + 0) * 65 + k] = v[i][0]; scr[(n4 + 1) * 65 + k] = v[i][1]; scr[(n4 + 2) * 65 + k] = v[i][2]; scr[(n4 + 3) * 65 + k] = v[i][3]; }
    LDS_WAIT(); asm volatile("" ::: "memory");
    const int c = lane & 7;
#pragma unroll
    for (int j = 0; j < 8; ++j) { const int nl = (lane >> 3) + 8 * j, n = n0 + nl; const int dr = wt_map<MAPK>(n); const LAS float* s = scr + nl * 65 + 8 * c;
        u32x4 o; o.x = cvt_pk_bf16(s[0], s[1]); o.y = cvt_pk_bf16(s[2], s[3]); o.z = cvt_pk_bf16(s[4], s[5]); o.w = cvt_pk_bf16(s[6], s[7]);
        if (n < N && dr >= 0) *(GAS u32x4*)(WT + (size_t)dr * K + k0 + 8 * c) = o; }
    LDS_WAIT(); asm volatile("" ::: "memory");
}
constexpr size_t MiB = 1u << 20;
constexpr size_t WS_CTL = 0, CTL_ZERO_BYTES = 1 * MiB;
constexpr size_t WS_WIN = 2 * MiB, WS_WO = 26 * MiB, WS_WCQ = 34 * MiB, WS_WCK = 42 * MiB, WS_WCV = 50 * MiB, WS_WCO = 58 * MiB;
constexpr size_t WS_WGU = 66 * MiB, WS_WD = 578 * MiB;
constexpr size_t WS_XB = 834 * MiB, WS_Q = 898 * MiB, WS_K = 962 * MiB, WS_V = 1026 * MiB;
constexpr size_t WS_MEMB = 1090 * MiB, WS_KC = 1098 * MiB, WS_VT = 1130 * MiB;
constexpr size_t WS_LOGF = 1162 * MiB, WS_KB = 1163 * MiB, WS_KPART = 1164 * MiB;
constexpr size_t WS_ASGE = 1165 * MiB, WS_ASGR = WS_ASGE + 512 * 1024, WS_ASGG = 1166 * MiB;
constexpr size_t WS_STOK = 1167 * MiB;
constexpr size_t WS_ACT = 1171 * MiB, WS_YEXP = 1443 * MiB, WS_END = 1715 * MiB;
static_assert(WS_ACT + (size_t)MAXTILES * 256 * DM * 2 <= WS_YEXP && WS_YEXP + (size_t)MAXTILES * 256 * DM * 2 <= WS_END, "d_ws map");
constexpr int CW_TMO = 0, CW_CODE = 1;
constexpr int CW_BAR = 4096;
constexpr int CW_CNT = 16384;
static_assert((CW_CNT + NL * NE * 64) * 4 <= (int)CTL_ZERO_BYTES && CW_BAR + XCD_BAR_WORDS <= CW_CNT, "CTL words inside the memset region");
constexpr int RING_OFF = 0, RING_BYTES = 131072;
constexpr int XCH_OFF = RING_BYTES;
constexpr int MOE_OFF = XCH_OFF + 8192;
constexpr int ARGT_OFF = MOE_OFF + 288;
constexpr int MISC_OFF = MOE_OFF + 512;
static_assert(8 * TR_TILE_BYTES <= MOE_OFF, "prologue transpose tiles");
constexpr int LDS_BYTES = 147456;
static_assert(MISC_OFF + 128 <= LDS_BYTES, "LDS map");
constexpr int NPHASE = 2 + 12 * NL;

struct Args { const float* in[22]; float* out; unsigned char* ws; int ph_lo, ph_hi; };

struct KVOrder {
    int G, c;
    __device__ __forceinline__ bool next(int i, pg8::Unit& u) const {
        const long L = (long)i * G + c; if (L >= 512) return false;
        const int wgid = pg8::xcd_chunk((int)L, 512), l = wgid >> 7, r = wgid & 127, kind = r >> 6, rr = r & 63;
        const int pm = kind ? (rr & 3) : (rr & 15), pn = kind ? (rr >> 2) : (rr >> 4);
        u.abyte = (long)(kind ? WS_WCV + (size_t)l * 2 * MiB : WS_MEMB) + (long)pm * 256 * DM * 2;
        u.bbyte = (long)(kind ? WS_MEMB : WS_WCK + (size_t)l * 2 * MiB) + (long)pn * 256 * DM * 2;
        u.orow = pm * 256; u.ocol = pn * 256; u.aux = l * 2 + kind; u.grow = 0; u.gcnt = 256; return true;
    }
};
struct EpiKV {
    static constexpr bool PERM = true;
    bf16_t* KC; bf16_t* VT;
    __device__ __forceinline__ void operator()(const f32x4 (&acc)[2][2][4][2], const pg8::Unit& u, const pg8::EpiCtx& c) const {
        const int l = u.aux >> 1, kind = u.aux & 1, ldc = kind ? TM : DM;
        bf16_t* O = (kind ? VT : KC) + (size_t)l * TM * DM;
        const int row0 = u.orow + c.wr * 64 + c.fr, col0 = u.ocol + c.wc * 32 + 8 * c.fq;
#pragma unroll
        for (int ai = 0; ai < 2; ++ai)
#pragma unroll
            for (int m = 0; m < 4; ++m) { bf16_t* rowp = O + (size_t)(row0 + ai * 128 + m * 16) * ldc + col0;
#pragma unroll
                for (int bj = 0; bj < 2; ++bj) { const f32x4 v0 = acc[ai][bj][m][0], v1 = acc[ai][bj][m][1];
                    u32x4 w; w.x = cvt_pk_bf16(v0[0], v0[1]); w.y = cvt_pk_bf16(v0[2], v0[3]); w.z = cvt_pk_bf16(v1[0], v1[1]); w.w = cvt_pk_bf16(v1[2], v1[3]);
                    *(u32x4*)(rowp + bj * 128) = w; } }
    }
};

#define PHASE_TID() int lane_; asm volatile("v_mbcnt_lo_u32_b32 %0, -1, 0\n\tv_mbcnt_hi_u32_b32 %0, -1, %0" : "=v"(lane_)); const int lane = lane_; const int wave = wave0; const int ptid = wave * 64 + lane; (void)lane; (void)wave; (void)ptid
__device__ __forceinline__ const float* argp(const LAS unsigned long long* tab, int i) {
    const unsigned long long v = tab[i]; const unsigned lo = __builtin_amdgcn_readfirstlane((unsigned)v), hi = __builtin_amdgcn_readfirstlane((unsigned)(v >> 32));
    return (const float*)(const GAS float*)(((unsigned long long)hi << 32) | lo);
}
__global__ void __launch_bounds__(NWAVES * 64, 2) skel_fwd(Args args) {
    extern __shared__ __attribute__((aligned(16))) unsigned char lds_raw[];
    LAS unsigned char* lds = (LAS unsigned char*)lds_raw;
    volatile LAS unsigned* MISC = (volatile LAS unsigned*)(lds + MISC_OFF);
    const int G = gridDim.x; const int bx = blockIdx.x; const int vcu = (G % 8 == 0) ? (bx % 8) * (G / 8) + bx / 8 : bx;
    const int lo = args.ph_lo, hi = args.ph_hi;
    const int wave0 = __builtin_amdgcn_readfirstlane((int)threadIdx.x >> 6);
    LAS unsigned long long* ARGT = (LAS unsigned long long*)(lds + ARGT_OFF);
    { const int tid0 = threadIdx.x;
      for (int u = tid0; u < (LDS_BYTES - XCH_OFF) / 4; u += NWAVES * 64) ((LAS unsigned*)(lds + XCH_OFF))[u] = 0u;
      __syncthreads();
      if (tid0 == 0) {
#pragma unroll
          for (int i = 0; i < 22; ++i) ARGT[i] = (unsigned long long)args.in[i];
          ARGT[22] = (unsigned long long)args.out; ARGT[23] = (unsigned long long)args.ws; }
      __syncthreads(); }
    if (hi - lo > 1) { const XcdBarrier b0 = xcd_barrier_post((unsigned*)(args.ws + WS_CTL) + CW_BAR, MISC + 8); if (threadIdx.x == 0) MISC[10] = b0.x; }
    __syncthreads();
#ifndef PHASE_MASK
#define PHASE_MASK 0xFFFF
#endif
#define PH_ON(kind) (((PHASE_MASK) >> (kind)) & 1)
#ifndef REPEAT_MASK
#define REPEAT_MASK 0
#endif
#define REP(kind) for (int rep_ = 0; rep_ <= (((REPEAT_MASK) >> (kind)) & 1); ++rep_)
#define IN(k) (lo <= (k) && (k) < hi)
#define BOTH(k) (IN(k) && IN((k) + 1))
#define SEAM(k) do { if (BOTH(k)) { XcdBarrier b_; b_.bar = (unsigned*)WSP() + CW_BAR; b_.x = (unsigned)__builtin_amdgcn_readfirstlane((int)MISC[10]); b_.st = MISC + 8; xcd_barrier(b_); } } while (0)
#define ARGF(i) argp(ARGT, (i))
#define WSP() ((unsigned char*)ARGF(23))
    LAS int* TP = (LAS int*)(lds + MOE_OFF); LAS int* CNT = TP + 40;
    LAS unsigned char* xch = lds + XCH_OFF;
    const int NGW = G * NWAVES;

    REP(0) if (PH_ON(0) && IN(0)) {
        PHASE_TID(); unsigned char* ws = WSP(); const int gw = vcu * NWAVES + wave;
        const float* x_in = ARGF(0); const float* mem = ARGF(1); const float* w_in = ARGF(2); const float* b_forget = ARGF(3); const float* w_mix_out = ARGF(4);
        const float* w_cq = ARGF(8); const float* w_ck = ARGF(9); const float* w_cv = ARGF(10); const float* w_co = ARGF(11); const float* w_gate_up = ARGF(16); const float* w_down = ARGF(18);
        LAS float* scr = (LAS float*)(lds + RING_OFF + wave * TR_TILE_BYTES);
        constexpr int I_IN = 16 * 49, I_SQ = 16 * 16, I_GU = 16 * 32, PER_L = I_IN + 5 * I_SQ + NE * I_GU + NE * I_SQ;
        for (int it = gw; it < NL * PER_L; it += NGW) {
            const int l = it / PER_L; int r = it % PER_L;
            if (r < I_IN) { transpose_item<1>(w_in + (size_t)l * DM * IN_COLS, DM, IN_COLS, (bf16_t*)(ws + WS_WIN) + (size_t)l * IN_N * DM, scr, r, lane); continue; } r -= I_IN;
            if (r < 5 * I_SQ) { const int which = r / I_SQ, item = r % I_SQ;
                const float* W = (which == 0 ? w_mix_out : which == 1 ? w_cq : which == 2 ? w_ck : which == 3 ? w_cv : w_co) + (size_t)l * DM * DM;
                bf16_t* WT = (bf16_t*)(ws + (which == 0 ? WS_WO : which == 1 ? WS_WCQ : which == 2 ? WS_WCK : which == 3 ? WS_WCV : WS_WCO)) + (size_t)l * DM * DM;
                transpose_item<0>(W, DM, DM, WT, scr, item, lane); continue; } r -= 5 * I_SQ;
            if (r < NE * I_GU) { const int e = r / I_GU, item = r % I_GU;
                transpose_item<2>(w_gate_up + (size_t)(l * NE + e) * DM * 2048, DM, 2048, (bf16_t*)(ws + WS_WGU) + (size_t)(l * NE + e) * 2048 * DM, scr, item, lane); continue; } r -= NE * I_GU;
            { const int e = r / I_SQ, item = r % I_SQ;
                transpose_item<0>(w_down + (size_t)(l * NE + e) * DM * DM, DM, DM, (bf16_t*)(ws + WS_WD) + (size_t)(l * NE + e) * DM * DM, scr, item, lane); }
        }
        __syncthreads();
        LAS float* wf = (LAS float*)(lds + RING_OFF);
        load_wf(w_in, wf, ptid);
        __syncthreads();
        bf16_t* XB = (bf16_t*)(ws + WS_XB); float* LOGF = (float*)(ws + WS_LOGF); bf16_t* MEMB = (bf16_t*)(ws + WS_MEMB);
        for (int rg = gw; rg < T / 16; rg += NGW)
            for (int g4 = 0; g4 < 4; ++g4) { const int t0 = rg * 16 + g4 * 4; f32x4 xn[4][4];
#pragma unroll
                for (int r = 0; r < 4; ++r) { row_load(x_in + (size_t)(t0 + r) * DM, lane, xn[r]); row_store_bf16(XB + (size_t)(t0 + r) * DM, lane, xn[r]); }
                forget_rows(xn, wf, b_forget, LOGF, t0, lane); }
        for (int m = gw; m < TM; m += NGW) { f32x4 v[4]; row_load(mem + (size_t)m * DM, lane, v); row_store_bf16(MEMB + (size_t)m * DM, lane, v); }
        __syncthreads();
        SEAM(0);
    }
    REP(1) if (PH_ON(1) && IN(1)) {
        PHASE_TID(); unsigned char* ws = WSP();
        pg8::Gemm g{(const bf16_t*)ws, (const bf16_t*)ws, DM, DM, DM, nullptr}; KVOrder S{G, bx}; EpiKV E{(bf16_t*)(ws + WS_KC), (bf16_t*)(ws + WS_VT)};
        pg8::gemm_phase<EpiKV, KVOrder, false, true>(ptid, lds + RING_OFF, xch, g, S, E);
        SEAM(1);
    }
    for (int l = 0; l < NL; ++l) {
        const int pb = 2 + 12 * l;
        REP(2) if (PH_ON(2) && IN(pb + 0)) {
            PHASE_TID(); unsigned char* ws = WSP();
            { float* LOGF = (float*)(ws + WS_LOGF); float* KBIAS = (float*)(ws + WS_KB);
              for (int sq = bx; sq < NB * 8; sq += G) {
                const f32x4 v = *(const f32x4*)(LOGF + (size_t)sq * SEQ + ptid * 4);
                const float p0 = v[0], p1 = p0 + v[1], p2 = p1 + v[2], p3 = p2 + v[3];
                float inc = p3;
#pragma unroll
                for (int o = 1; o < 64; o <<= 1) { const float n = __shfl_up(inc, o); if (lane >= o) inc += n; }
                LAS float* wt = (LAS float*)xch;
                if (lane == 63) wt[wave] = inc;
                __syncthreads();
                float off = inc - p3;
                for (int w = 0; w < wave; ++w) off += wt[w];
                f32x4 o; o[0] = -(off + p0) * LOG2E; o[1] = -(off + p1) * LOG2E; o[2] = -(off + p2) * LOG2E; o[3] = -(off + p3) * LOG2E;
                *(f32x4*)(KBIAS + (size_t)sq * SEQ + ptid * 4) = o;
                __syncthreads();
              } }
            pg8::Gemm g{(const bf16_t*)(ws + WS_XB), (const bf16_t*)(ws + WS_WIN) + (size_t)l * IN_N * DM, DM, DM, DM, nullptr};
            pg8::GridOrder<0> S; S.init(T / 256, IN_N / 256, G, bx, DM, DM);
            pg8::EpiQKV E{(bf16_t*)(ws + WS_Q), (bf16_t*)(ws + WS_K), (bf16_t*)(ws + WS_V), (float*)(ws + WS_KPART)};
            pg8::gemm_phase<pg8::EpiQKV, pg8::GridOrder<0>, false, true>(ptid, lds + RING_OFF, xch, g, S, E);
            SEAM(pb + 0);
        }
        REP(3) if (PH_ON(3) && IN(pb + 1)) {
            PHASE_TID(); unsigned char* ws = WSP();
            const attn_body::AttnTensors AT{(const attn_body::bf16*)(ws + WS_Q), (const attn_body::bf16*)(ws + WS_K), (const attn_body::bf16*)(ws + WS_V), (attn_body::bf16*)(ws + WS_Q)};
            const attn_body::StaticOrder S(G, vcu);
            attn_body::attn_phase<attn_body::StaticOrder>(ptid, (char*)lds_raw + RING_OFF, AT, S, (const float*)(ws + WS_KB), (const float*)(ws + WS_KPART), ARGF(5));
            SEAM(pb + 1);
        }
        REP(4) if (PH_ON(4) && IN(pb + 2)) {
            PHASE_TID(); unsigned char* ws = WSP(); float* X = (float*)ARGF(22);
            pg8::Gemm g{(const bf16_t*)(ws + WS_Q), (const bf16_t*)(ws + WS_WO) + (size_t)l * DM * DM, DM, DM, DM, nullptr};
            pg8::GridOrder<0> S; S.init(T / 256, DM / 256, G, bx, DM, DM);
            pg8::EpiResid E{l == 0 ? ARGF(0) : (const float*)X, X};
            pg8::gemm_phase<pg8::EpiResid, pg8::GridOrder<0>, false, true>(ptid, lds + RING_OFF, xch, g, S, E);
            SEAM(pb + 2);
        }
        REP(5) if (PH_ON(5) && IN(pb + 3)) {
            PHASE_TID(); unsigned char* ws = WSP(); float* X = (float*)ARGF(22); bf16_t* XB = (bf16_t*)(ws + WS_XB); const int gw = vcu * NWAVES + wave;
            f32x4 gg[4], bb[4]; row_load(ARGF(6) + (size_t)l * DM, lane, gg); row_load(ARGF(7) + (size_t)l * DM, lane, bb);
            for (int rg = gw; rg < T / 16; rg += NGW)
                for (int r = 0; r < 16; ++r) { const size_t t = (size_t)rg * 16 + r; f32x4 v[4]; row_load(X + t * DM, lane, v); row_layernorm(v, gg, bb);
                    row_store_f32(X + t * DM, lane, v); row_store_bf16(XB + t * DM, lane, v); }
            SEAM(pb + 3);
        }
        REP(6) if (PH_ON(6) && IN(pb + 4)) {
            PHASE_TID(); unsigned char* ws = WSP();
            pg8::Gemm g{(const bf16_t*)(ws + WS_XB), (const bf16_t*)(ws + WS_WCQ) + (size_t)l * DM * DM, DM, DM, DM, nullptr};
            pg8::GridOrder<0> S; S.init(T / 256, DM / 256, G, bx, DM, DM);
            pg8::EpiBf16S E{(bf16_t*)(ws + WS_Q), DM, C2_CROSS, nullptr, 0, 1};
            pg8::gemm_phase<pg8::EpiBf16S, pg8::GridOrder<0>, false, true>(ptid, lds + RING_OFF, xch, g, S, E);
            SEAM(pb + 4);
        }
        REP(7) if (PH_ON(7) && IN(pb + 5)) {
            PHASE_TID(); unsigned char* ws = WSP();
            pg8::Gemm g{(const bf16_t*)(ws + WS_Q), (const bf16_t*)(ws + WS_KC) + (size_t)l * TM * DM, DM, DM, 256, nullptr};
            pg8::GridOrder<1> S; S.init(T / 256, 4, G, bx, DM, DM);
            pg8::EpiSoftmax E{(bf16_t*)(ws + WS_K)};
            pg8::gemm_phase<pg8::EpiSoftmax, pg8::GridOrder<1>, false, true>(ptid, lds + RING_OFF, xch, g, S, E);
            SEAM(pb + 5);
        }
        REP(8) if (PH_ON(8) && IN(pb + 6)) {
            PHASE_TID(); unsigned char* ws = WSP();
            pg8::Gemm g{(const bf16_t*)(ws + WS_K), (const bf16_t*)(ws + WS_VT) + (size_t)l * TM * DM, DM, TM, 256, nullptr};
            pg8::GridOrder<2> S; S.init(T / 256, 4, G, bx, DM, TM);
            pg8::EpiBf16S E{(bf16_t*)(ws + WS_V), DM, 1.0f, nullptr, 0, 1};
            pg8::gemm_phase<pg8::EpiBf16S, pg8::GridOrder<2>, false, true>(ptid, lds + RING_OFF, xch, g, S, E);
            SEAM(pb + 6);
        }
        REP(9) if (PH_ON(9) && IN(pb + 7)) {
            PHASE_TID(); unsigned char* ws = WSP(); float* X = (float*)ARGF(22);
            pg8::Gemm g{(const bf16_t*)(ws + WS_V), (const bf16_t*)(ws + WS_WCO) + (size_t)l * DM * DM, DM, DM, DM, nullptr};
            pg8::GridOrder<0> S; S.init(T / 256, DM / 256, G, bx, DM, DM);
            pg8::EpiResid E{X, X};
            pg8::gemm_phase<pg8::EpiResid, pg8::GridOrder<0>, false, true>(ptid, lds + RING_OFF, xch, g, S, E);
            SEAM(pb + 7);
        }
        REP(10) if (PH_ON(10) && IN(pb + 8)) {
            PHASE_TID(); unsigned char* ws = WSP(); float* X = (float*)ARGF(22); bf16_t* XB = (bf16_t*)(ws + WS_XB); const int gw = vcu * NWAVES + wave; gu32* ctl = (gu32*)ws;
            const float* w_router = ARGF(14); const float* b_router = ARGF(15); const float* ln2_g = ARGF(12); const float* ln2_b = ARGF(13);
            int* ASGE = (int*)(ws + WS_ASGE); int* ASGR = (int*)(ws + WS_ASGR); float* ASGG = (float*)(ws + WS_ASGG); int* STOK = (int*)(ws + WS_STOK);
            const int tid = ptid;
            constexpr int RWS = 1028;
            LAS float* wl = (LAS float*)(lds + RING_OFF);
            LAS int* sE = (LAS int*)(lds + RING_OFF + NE * RWS * 4); LAS float* sG = (LAS float*)(sE + 512); LAS int* cntw = (LAS int*)(sG + 512); LAS int* basew = cntw + 256;
            { const float* wr_l = w_router + (size_t)l * DM * NE;
              for (int idx = tid; idx < DM * NE / 4; idx += NWAVES * 64) { const int k = idx >> 3, e4 = (idx & 7) * 4; const f32x4 w4 = *(const f32x4*)(wr_l + (size_t)k * NE + e4);
                  wl[(e4 + 0) * RWS + k] = w4[0]; wl[(e4 + 1) * RWS + k] = w4[1]; wl[(e4 + 2) * RWS + k] = w4[2]; wl[(e4 + 3) * RWS + k] = w4[3]; } }
            __syncthreads();
            gu32* cnt_l = ctl + CW_CNT + l * NE * 64;
            for (int rg = gw; rg < T / 16; rg += NGW) {
#pragma unroll 1
                for (int g4 = 0; g4 < 4; ++g4) {
                    int lo_ = lane; asm volatile("" : "+v"(lo_));
                    const int t0 = rg * 16 + g4 * 4; f32x4 xn[4][4];
                    { f32x4 gg[4], bb[4]; row_load(ln2_g + (size_t)l * DM, lo_, gg); row_load(ln2_b + (size_t)l * DM, lo_, bb);
#pragma unroll
                      for (int r = 0; r < 4; ++r) { const size_t t = (size_t)(t0 + r); row_load(X + t * DM, lo_, xn[r]); row_layernorm(xn[r], gg, bb);
                          row_store_f32(X + t * DM, lo_, xn[r]); row_store_bf16(XB + t * DM, lo_, xn[r]); } }
                    float vv[4]; const int eb = (lo_ >> 1) & 7;
#pragma unroll
                    for (int c = 0; c < 4; ++c) { const LAS float* wlo = wl + c * 8 * RWS; asm volatile("" : "+v"(wlo));
                        float acc[32]; thin_dot<8>(xn, wlo, RWS, lo_, acc); butterfly32(acc, lo_); vv[c] = acc[0] + b_router[l * NE + c * 8 + eb]; }
                    float topv[4]; int tope[4];
#pragma unroll
                    for (int k = 0; k < 4; ++k) { float bv = vv[0]; int be = eb;
#pragma unroll
                        for (int c = 1; c < 4; ++c) { if (vv[c] > bv) { bv = vv[c]; be = c * 8 + eb; } }
#pragma unroll
                        for (int o = 1; o < 16; o <<= 1) { const float ov = __shfl_xor(bv, o); const int oe = __shfl_xor(be, o); const bool take = (ov > bv) || (ov == bv && oe < be); bv = take ? ov : bv; be = take ? oe : be; }
                        topv[k] = bv; tope[k] = be;
#pragma unroll
                        for (int c = 0; c < 4; ++c) if (be == c * 8 + eb) vv[c] = -INFINITY; }
                    const float p1 = __expf(topv[1] - topv[0]), p2 = __expf(topv[2] - topv[0]), p3 = __expf(topv[3] - topv[0]); const float rs = 1.0f / (1.0f + p1 + p2 + p3);
                    const int kk = lo_ & 15;
                    if (kk < 4) { const int me = kk == 0 ? tope[0] : kk == 1 ? tope[1] : kk == 2 ? tope[2] : tope[3]; const float mg = (kk == 0 ? 1.0f : kk == 1 ? p1 : kk == 2 ? p2 : p3) * rs;
                        const int slot = wave * 64 + (g4 * 4 + (lo_ >> 4)) * 4 + kk; sE[slot] = me; sG[slot] = mg; }
                }
                LDS_WAIT();
                int lq_ = lane; asm volatile("" : "+v"(lq_));
                const int my_e = sE[wave * 64 + lq_]; const float my_g = sG[wave * 64 + lq_]; const int my_t = rg * 16 + (lq_ >> 2);
                int lr = 0, mycnt = 0;
#pragma unroll 1
                for (int e = 0; e < NE; ++e) { const unsigned long long m = __ballot(my_e == e); if (my_e == e) lr = __popcll(m & ((1ull << lq_) - 1ull)); if (lq_ == e) mycnt = __popcll(m); }
                if (lq_ < NE) cntw[wave * NE + lq_] = mycnt;
                __syncthreads();
                int tq_ = tid; asm volatile("" : "+v"(tq_));
                if (tq_ < NE) { int tot = 0; int c8[NWAVES];
#pragma unroll
                    for (int w = 0; w < NWAVES; ++w) { c8[w] = cntw[w * NE + tq_]; tot += c8[w]; }
                    int base = 0; if (tot > 0) base = (int)__hip_atomic_fetch_add(cnt_l + tq_ * 64, (unsigned)tot, __ATOMIC_RELAXED, __HIP_MEMORY_SCOPE_AGENT);
#pragma unroll
                    for (int w = 0; w < NWAVES; ++w) { basew[w * NE + tq_] = base; base += c8[w]; } }
                __syncthreads();
                const int rank = basew[wave * NE + my_e] + lr;
                ASGE[(size_t)my_t * 4 + (lq_ & 3)] = my_e; ASGR[(size_t)my_t * 4 + (lq_ & 3)] = rank; ASGG[(size_t)my_t * 4 + (lq_ & 3)] = my_g;
                STOK[(size_t)my_e * ECAP + rank] = my_t;
                __syncthreads();
            }
            SEAM(pb + 8);
        }
        if ((PH_ON(11) && IN(pb + 9)) || (PH_ON(12) && IN(pb + 10)) || (PH_ON(13) && IN(pb + 11))) {
            PHASE_TID(); gu32* ctl = (gu32*)WSP();
            __syncthreads();
            if (ptid < NE) CNT[ptid] = (int)__hip_atomic_load(ctl + CW_CNT + (l * NE + ptid) * 64, __ATOMIC_RELAXED, __HIP_MEMORY_SCOPE_AGENT);
            __syncthreads();
            if (ptid == 0) { int a = 0; for (int e = 0; e < NE; ++e) { TP[e] = a; a += (CNT[e] + 255) >> 8; } TP[NE] = a; }
            __syncthreads();
        }
        REP(11) if (PH_ON(11) && IN(pb + 9)) {
            PHASE_TID(); unsigned char* ws = WSP();
            pg8::Gemm g{(const bf16_t*)(ws + WS_XB), (const bf16_t*)(ws + WS_WGU) + (size_t)l * NE * 2048 * DM, DM, DM, DM, (const int*)(ws + WS_STOK)};
            pg8::MoeOrder<8, true> S; S.init(TP, CNT, G, bx);
            pg8::EpiSwiglu E{(bf16_t*)(ws + WS_ACT), ARGF(17) + (size_t)l * NE * 2048};
            pg8::gemm_phase<pg8::EpiSwiglu, pg8::MoeOrder<8, true>, true, true>(ptid, lds + RING_OFF, xch, g, S, E);
            SEAM(pb + 9);
        }
        REP(12) if (PH_ON(12) && IN(pb + 10)) {
            PHASE_TID(); unsigned char* ws = WSP();
            pg8::Gemm g{(const bf16_t*)(ws + WS_ACT), (const bf16_t*)(ws + WS_WD) + (size_t)l * NE * DM * DM, DM, DM, DM, nullptr};
            pg8::MoeOrder<4, false> S; S.init(TP, CNT, G, bx);
            pg8::EpiBf16S E{(bf16_t*)(ws + WS_YEXP), DM, 1.0f, ARGF(19) + (size_t)l * NE * DM, DM, 256};
            pg8::gemm_phase<pg8::EpiBf16S, pg8::MoeOrder<4, false>, false, true>(ptid, lds + RING_OFF, xch, g, S, E);
            SEAM(pb + 10);
        }
        REP(13) if (PH_ON(13) && IN(pb + 11)) {
            PHASE_TID(); unsigned char* ws = WSP(); float* X = (float*)ARGF(22); const int gw = vcu * NWAVES + wave;
            bf16_t* XB = (bf16_t*)(ws + WS_XB); const int* ASGE = (const int*)(ws + WS_ASGE); const int* ASGR = (const int*)(ws + WS_ASGR); const float* ASGG = (const float*)(ws + WS_ASGG);
            const bf16_t* YEXP = (const bf16_t*)(ws + WS_YEXP); float* LOGF = (float*)(ws + WS_LOGF); const float* b_forget = ARGF(3);
            LAS float* wf = (LAS float*)(lds + RING_OFF);
            if (l + 1 < NL) { load_wf(ARGF(2) + (size_t)(l + 1) * DM * IN_COLS, wf, ptid); __syncthreads(); }
            f32x4 gg[4], bb[4]; row_load(ARGF(20) + (size_t)l * DM, lane, gg); row_load(ARGF(21) + (size_t)l * DM, lane, bb);
            for (int rg = gw; rg < T / 16; rg += NGW)
                for (int g4 = 0; g4 < 4; ++g4) { const int t0 = rg * 16 + g4 * 4; f32x4 xn[4][4];
#pragma unroll
                    for (int r = 0; r < 4; ++r) { const size_t t = (size_t)(t0 + r);
                        row_load(X + t * DM, lane, xn[r]);
#pragma unroll
                        for (int j = 0; j < 4; ++j) xn[r][j] = xn[r][j] * DN_ALPHA;
#pragma unroll
                        for (int k = 0; k < 4; ++k) { const int e = ASGE[t * 4 + k], rk = ASGR[t * 4 + k]; const float gt = ASGG[t * 4 + k];
                            const GAS u32x2* yr = (const GAS u32x2*)(YEXP + ((size_t)TP[e] * 256 + rk) * DM) + lane;
#pragma unroll
                            for (int j = 0; j < 4; ++j) { const u32x2 w = yr[64 * j];
                                xn[r][j][0] += gt * __uint_as_float(w.x << 16); xn[r][j][1] += gt * __uint_as_float(w.x & 0xffff0000u);
                                xn[r][j][2] += gt * __uint_as_float(w.y << 16); xn[r][j][3] += gt * __uint_as_float(w.y & 0xffff0000u); } }
                        row_layernorm(xn[r], gg, bb); row_store_bf16(XB + t * DM, lane, xn[r]); row_store_f32(X + t * DM, lane, xn[r]); }
                    if (l + 1 < NL) forget_rows(xn, wf, b_forget + (l + 1) * 8, LOGF, t0, lane); }
            __syncthreads();
            SEAM(pb + 11);
        }
    }
#undef IN
#undef BOTH
#undef SEAM
}

#ifndef MK_PER_PHASE
#define MK_PER_PHASE 0
#endif
extern "C" void kernel_launch(void* const* d_in, const int* in_sizes, int n_in, void* d_out, int out_size, void* d_ws, size_t ws_size, hipStream_t stream) {
    static int grid = 0;
    if (grid == 0) {
        if (n_in != 22 || in_sizes[0] != T * DM || out_size != T * DM || ws_size < WS_END) {
            fprintf(stderr, "kernel_launch: built for 22 inputs, x/out of %d floats, >= %zu bytes of workspace; got n_in %d, in0 %d, out %d, ws %zu; nothing launched\n", T * DM, (size_t)WS_END, n_in, n_in > 0 ? in_sizes[0] : -1, out_size, ws_size); grid = -1; return; }
        int dev = 0, cus = 0, per_cu = 0;
        if (hipGetDevice(&dev) != hipSuccess || hipDeviceGetAttribute(&cus, hipDeviceAttributeMultiprocessorCount, dev) != hipSuccess) { fprintf(stderr, "kernel_launch: device query failed\n"); grid = -1; return; }
        if (hipFuncSetAttribute((const void*)skel_fwd, hipFuncAttributeMaxDynamicSharedMemorySize, LDS_BYTES) != hipSuccess) { fprintf(stderr, "kernel_launch: hipFuncSetAttribute failed\n"); grid = -1; return; }
        if (hipOccupancyMaxActiveBlocksPerMultiprocessor(&per_cu, (const void*)skel_fwd, NWAVES * 64, LDS_BYTES) != hipSuccess || per_cu < 1)
            fprintf(stderr, "kernel_launch: note: occupancy query reports %d workgroups per CU\n", per_cu);
        (void)hipGetLastError();
        grid = cus;
    }
    if (grid < 0) return;
    if (hipMemsetAsync((char*)d_ws + WS_CTL, 0, CTL_ZERO_BYTES, stream) != hipSuccess) { fprintf(stderr, "kernel_launch: memset failed\n"); return; }
    Args a{};
    for (int i = 0; i < 22; ++i) a.in[i] = (const float*)d_in[i];
    a.out = (float*)d_out; a.ws = (unsigned char*)d_ws;
#if MK_PER_PHASE
    for (int p = 0; p < NPHASE; ++p) { a.ph_lo = p; a.ph_hi = p + 1; hipLaunchKernelGGL(skel_fwd, dim3(grid), dim3(NWAVES * 64), LDS_BYTES, stream, a); }
#else
    a.ph_lo = 0; a.ph_hi = NPHASE; hipLaunchKernelGGL(skel_fwd, dim3(grid), dim3(NWAVES * 64), LDS_BYTES, stream, a);
#endif
    const hipError_t le = hipPeekAtLastError();
    if (le != hipSuccess) fprintf(stderr, "kernel_launch: launch failed: %s\n", hipGetErrorName(le));
}
```
